# Optimizing an MI355X kernel written in HIP

```python
import jax, jax.numpy as jnp
from jax import lax
import numpy as np


D_MODEL = 1024
BATCH = 8
SEQ = 2048
DEPTH = 4

D_MIX = D_MODEL
D_NSA = D_MIX // 2
D_LRU = D_MIX - D_NSA
NSA_HEADS = 8
NSA_HEAD_DIM = D_NSA // NSA_HEADS
NSA_KV_GROUPS = 2
NSA_REP = NSA_HEADS // NSA_KV_GROUPS
NSA_KV_W = NSA_KV_GROUPS * NSA_HEAD_DIM
N_BRANCH = 3
CMP_LEN = 32
CMP_STRIDE = 16
CMP_HIDDEN = 4 * NSA_HEAD_DIM
SEL_BLOCK = 64
SEL_TOP_K = 8
WINDOW = 512
Q_BLOCK = 128
LRU_BLOCKS = 8
LRU_BLOCK_W = D_LRU // LRU_BLOCKS
LRU_CONV_W = 4
LRU_C = 8.0
D_FF = 2816
FFN_CONV_W = 3
NORM_EPS = 1e-6
NEG_INF = -1e30
FORCE_BONUS = 1e4
IN_COLS = D_NSA + 6 * NSA_KV_W + N_BRANCH * NSA_HEADS + 2 * D_LRU

kernel_name = 'hymba_nsa_rglru_convffn_adaln'


def _in_splits():
    widths = [D_NSA] + [NSA_KV_W] * 6 + [N_BRANCH * NSA_HEADS, D_LRU, D_LRU]
    return [int(v) for v in np.cumsum(widths)[:-1]]


def _rmsnorm(x, g):
    xf = x.astype(jnp.float32)
    y = xf * lax.rsqrt(jnp.mean(xf * xf, axis=-1, keepdims=True) + NORM_EPS)
    return y.astype(x.dtype) * g


def _masked_softmax(s, mask):
    s = jnp.where(mask, s.astype(jnp.float32), NEG_INF)
    return jnp.where(mask, jax.nn.softmax(s, axis=-1), 0.0)


def _causal_dwconv(x, w, b):
    width = w.shape[0]
    seq = x.shape[1]
    xp = jnp.pad(x, ((0, 0), (width - 1, 0), (0, 0)))
    y = b
    for k in range(width):
        y = y + xp[:, k:k + seq] * w[k]
    return y


def _split_q(z):
    B, S, _ = z.shape
    return z.reshape(B, S, NSA_KV_GROUPS, NSA_REP, NSA_HEAD_DIM).transpose(0, 2, 3, 1, 4)


def _split_kv(z):
    B, S, _ = z.shape
    return z.reshape(B, S, NSA_KV_GROUPS, NSA_HEAD_DIM).transpose(0, 2, 1, 3)


def _compress(k, pos, w1, b1, w2, b2):
    S = k.shape[2]
    nc = (S - CMP_LEN) // CMP_STRIDE + 1
    idx = np.arange(nc)[:, None] * CMP_STRIDE + np.arange(CMP_LEN)[None, :]
    blocks = k[:, :, idx] + pos
    flat = blocks.reshape(blocks.shape[0], blocks.shape[1], nc, CMP_LEN * NSA_HEAD_DIM)
    return jax.nn.gelu(flat @ w1 + b1) @ w2 + b2


def _nsa_mixer(zq, zkc, zvc, zks, zvs, zkw, zvw, zg, gate_b, cmp_pos, cmp_w1, cmp_b1, cmp_w2, cmp_b2):
    B, S, _ = zq.shape
    G, R, DH = NSA_KV_GROUPS, NSA_REP, NSA_HEAD_DIM
    scale = DH ** -0.5
    t = jnp.arange(S)
    q = _split_q(zq)

    kc = _compress(_split_kv(zkc), cmp_pos[0], cmp_w1[0], cmp_b1[0], cmp_w2[0], cmp_b2[0])
    vc = _compress(_split_kv(zvc), cmp_pos[1], cmp_w1[1], cmp_b1[1], cmp_w2[1], cmp_b2[1])
    nc = kc.shape[2]
    cmp_start = jnp.arange(nc) * CMP_STRIDE
    mask_c = (cmp_start + CMP_LEN - 1)[None, :] <= t[:, None]
    p_cmp = _masked_softmax(jnp.einsum('bgrsd,bgcd->bgrsc', q, kc) * scale, mask_c)
    o_cmp = jnp.einsum('bgrsc,bgcd->bgrsd', p_cmp.astype(vc.dtype), vc)

    nb = S // SEL_BLOCK
    js = jnp.arange(nb) * SEL_BLOCK
    overlap = ((cmp_start[:, None] < js[None, :] + SEL_BLOCK) & (cmp_start[:, None] + CMP_LEN > js[None, :])).astype(jnp.float32)
    imp = jnp.einsum('bgrsc,cj->bgsj', p_cmp, overlap)
    qblk = t // SEL_BLOCK
    jb = jnp.arange(nb)[None, :]
    valid = jb <= qblk[:, None]
    forced = (jb == 0) | (jb == qblk[:, None]) | (jb == qblk[:, None] - 1)
    imp = jnp.where(valid, imp + jnp.where(forced, FORCE_BONUS, 0.0), NEG_INF)
    top_k = min(SEL_TOP_K, nb)
    _, sel = lax.top_k(imp, top_k)

    nq = S // Q_BLOCK
    ks_b = _split_kv(zks).reshape(B, G, nb, SEL_BLOCK, DH)
    vs_b = _split_kv(zvs).reshape(B, G, nb, SEL_BLOCK, DH)
    q_blk = q.reshape(B, G, R, nq, Q_BLOCK, DH).transpose(3, 0, 1, 2, 4, 5)
    sel_blk = sel.reshape(B, G, nq, Q_BLOCK, top_k).transpose(2, 0, 1, 3, 4)
    t_blk = t.reshape(nq, Q_BLOCK)
    bi = jnp.arange(B)[:, None, None, None]
    gi = jnp.arange(G)[None, :, None, None]
    n_sel = top_k * SEL_BLOCK

    def sel_attend(args):
        qb, ib, tb = args
        kg = ks_b[bi, gi, ib].reshape(B, G, Q_BLOCK, n_sel, DH)
        vg = vs_b[bi, gi, ib].reshape(B, G, Q_BLOCK, n_sel, DH)
        kpos = (ib[..., None] * SEL_BLOCK + jnp.arange(SEL_BLOCK)).reshape(B, G, Q_BLOCK, n_sel)
        mask = (kpos <= tb[:, None])[:, :, None]
        p = _masked_softmax(jnp.einsum('bgrqd,bgqnd->bgrqn', qb, kg) * scale, mask)
        return jnp.einsum('bgrqn,bgqnd->bgrqd', p.astype(vg.dtype), vg)

    o_slc = lax.map(sel_attend, (q_blk, sel_blk, t_blk))
    o_slc = o_slc.transpose(1, 2, 3, 0, 4, 5).reshape(B, G, R, S, DH)

    nw = WINDOW // Q_BLOCK + 1
    kp = jnp.pad(_split_kv(zkw), ((0, 0), (0, 0), (WINDOW, 0), (0, 0))).reshape(B, G, nq + nw - 1, Q_BLOCK, DH)
    vp = jnp.pad(_split_kv(zvw), ((0, 0), (0, 0), (WINDOW, 0), (0, 0))).reshape(B, G, nq + nw - 1, Q_BLOCK, DH)
    kband = jnp.concatenate([kp[:, :, i:i + nq] for i in range(nw)], axis=3)
    vband = jnp.concatenate([vp[:, :, i:i + nq] for i in range(nw)], axis=3)
    qw = q.reshape(B, G, R, nq, Q_BLOCK, DH)
    kpos = jnp.arange(nq)[:, None] * Q_BLOCK - WINDOW + jnp.arange(nw * Q_BLOCK)[None, :]
    kpos = kpos[:, None, :]
    tq = t_blk[:, :, None]
    mask_w = (kpos <= tq) & (kpos > tq - WINDOW) & (kpos >= 0)
    p_w = _masked_softmax(jnp.einsum('bgrnqd,bgnkd->bgrnqk', qw, kband) * scale, mask_w)
    o_win = jnp.einsum('bgrnqk,bgnkd->bgrnqd', p_w.astype(vband.dtype), vband).reshape(B, G, R, S, DH)

    g = jax.nn.sigmoid(zg + gate_b).reshape(B, S, G, R, N_BRANCH).transpose(0, 2, 3, 1, 4)
    o = g[..., 0:1] * o_cmp + g[..., 1:2] * o_slc + g[..., 2:3] * o_win
    return o.transpose(0, 3, 1, 2, 4).reshape(B, S, D_NSA)


def _lin_combine(c1, c2):
    a1, b1 = c1
    a2, b2 = c2
    return a1 * a2, a2 * b1 + b2


def _rglru_mixer(zx, zy, conv_w, conv_b, wa, ba, wx, bx, lam):
    B, S, _ = zx.shape
    xc = _causal_dwconv(zx, conv_w, conv_b)
    xh = xc.reshape(B, S, LRU_BLOCKS, LRU_BLOCK_W)
    r = jax.nn.sigmoid(jnp.einsum('bsnc,ncd->bsnd', xh, wa).reshape(B, S, D_LRU) + ba)
    i = jax.nn.sigmoid(jnp.einsum('bsnc,ncd->bsnd', xh, wx).reshape(B, S, D_LRU) + bx)
    log_a = LRU_C * r.astype(jnp.float32) * jax.nn.log_sigmoid(lam.astype(jnp.float32))
    a = jnp.exp(log_a)
    u = jnp.sqrt(-jnp.expm1(2.0 * log_a)) * (i * xc).astype(jnp.float32)
    _, h = lax.associative_scan(_lin_combine, (a, u), axis=1)
    return h.astype(zx.dtype) * jax.nn.gelu(zy)


def _conv_ffn(h, w_gate, w_up, conv_w, conv_b, w_down):
    gate = _causal_dwconv(h @ w_gate, conv_w, conv_b)
    return (jax.nn.silu(gate) * (h @ w_up)) @ w_down


def setup_inputs(seed: int = 0) -> dict:
    key = jax.random.key(seed)
    ks = jax.random.split(key, 32)

    def nrm(k, shape, scale):
        return jax.random.normal(k, shape, jnp.float32) * scale

    L = DEPTH
    lam_u = jax.random.uniform(ks[19], (L, D_LRU), jnp.float32, 0.9, 0.999)
    return {
        'x': nrm(ks[0], (BATCH, SEQ, D_MODEL), 1.0),
        'c': nrm(ks[1], (BATCH, D_MODEL), 1.0),
        'ada_w': nrm(ks[2], (L, D_MODEL, 6 * D_MODEL), 0.5 * D_MODEL ** -0.5),
        'ada_b': nrm(ks[3], (L, 6 * D_MODEL), 0.02),
        'mix_norm_g': 1.0 + nrm(ks[4], (L, D_MODEL), 0.02),
        'ffn_norm_g': 1.0 + nrm(ks[5], (L, D_MODEL), 0.02),
        'w_in': nrm(ks[6], (L, D_MODEL, IN_COLS), D_MODEL ** -0.5),
        'nsa_gate_b': nrm(ks[7], (L, N_BRANCH * NSA_HEADS), 0.1),
        'cmp_pos': nrm(ks[8], (L, 2, CMP_LEN, NSA_HEAD_DIM), 0.02),
        'cmp_w1': nrm(ks[9], (L, 2, CMP_LEN * NSA_HEAD_DIM, CMP_HIDDEN), (CMP_LEN * NSA_HEAD_DIM) ** -0.5),
        'cmp_b1': nrm(ks[10], (L, 2, CMP_HIDDEN), 0.01),
        'cmp_w2': nrm(ks[11], (L, 2, CMP_HIDDEN, NSA_HEAD_DIM), CMP_HIDDEN ** -0.5),
        'cmp_b2': nrm(ks[12], (L, 2, NSA_HEAD_DIM), 0.01),
        'lru_conv_w': nrm(ks[13], (L, LRU_CONV_W, D_LRU), LRU_CONV_W ** -0.5),
        'lru_conv_b': nrm(ks[14], (L, D_LRU), 0.01),
        'lru_wa': nrm(ks[15], (L, LRU_BLOCKS, LRU_BLOCK_W, LRU_BLOCK_W), LRU_BLOCK_W ** -0.5),
        'lru_ba': nrm(ks[16], (L, D_LRU), 0.01),
        'lru_wx': nrm(ks[17], (L, LRU_BLOCKS, LRU_BLOCK_W, LRU_BLOCK_W), LRU_BLOCK_W ** -0.5),
        'lru_bx': nrm(ks[18], (L, D_LRU), 0.01),
        'lru_lambda': jnp.log(lam_u) - jnp.log1p(-lam_u),
        'nsa_out_norm_g': 1.0 + nrm(ks[20], (L, D_NSA), 0.02),
        'lru_out_norm_g': 1.0 + nrm(ks[21], (L, D_LRU), 0.02),
        'w_out': nrm(ks[22], (L, D_MIX, D_MODEL), D_MIX ** -0.5),
        'ffn_w_gate': nrm(ks[23], (L, D_MODEL, D_FF), D_MODEL ** -0.5),
        'ffn_w_up': nrm(ks[24], (L, D_MODEL, D_FF), D_MODEL ** -0.5),
        'ffn_conv_w': nrm(ks[25], (L, FFN_CONV_W, D_FF), FFN_CONV_W ** -0.5),
        'ffn_conv_b': nrm(ks[26], (L, D_FF), 0.01),
        'ffn_w_down': nrm(ks[27], (L, D_FF, D_MODEL), D_FF ** -0.5),
        'final_norm_g': 1.0 + nrm(ks[28], (D_MODEL,), 0.02),
    }


def reference(x, c, ada_w, ada_b, mix_norm_g, ffn_norm_g, w_in, nsa_gate_b, cmp_pos, cmp_w1, cmp_b1, cmp_w2, cmp_b2, lru_conv_w, lru_conv_b, lru_wa, lru_ba, lru_wx, lru_bx, lru_lambda, nsa_out_norm_g, lru_out_norm_g, w_out, ffn_w_gate, ffn_w_up, ffn_conv_w, ffn_conv_b, ffn_w_down, final_norm_g):
    splits = _in_splits()
    c_act = jax.nn.silu(c)
    for l in range(DEPTH):
        mod = (c_act @ ada_w[l] + ada_b[l])[:, None, :]
        sh1, sc1, g1, sh2, sc2, g2 = jnp.split(mod, 6, axis=-1)

        h = _rmsnorm(x, mix_norm_g[l]) * (1.0 + sc1) + sh1
        z = h @ w_in[l]
        zq, zkc, zvc, zks, zvs, zkw, zvw, zg, zx, zy = jnp.split(z, splits, axis=-1)
        o_nsa = _nsa_mixer(zq, zkc, zvc, zks, zvs, zkw, zvw, zg, nsa_gate_b[l], cmp_pos[l], cmp_w1[l], cmp_b1[l], cmp_w2[l], cmp_b2[l])
        o_lru = _rglru_mixer(zx, zy, lru_conv_w[l], lru_conv_b[l], lru_wa[l], lru_ba[l], lru_wx[l], lru_bx[l], lru_lambda[l])
        mixed = jnp.concatenate([_rmsnorm(o_nsa, nsa_out_norm_g[l]), _rmsnorm(o_lru, lru_out_norm_g[l])], axis=-1)
        x = x + g1 * (mixed @ w_out[l])

        h = _rmsnorm(x, ffn_norm_g[l]) * (1.0 + sc2) + sh2
        x = x + g2 * _conv_ffn(h, ffn_w_gate[l], ffn_w_up[l], ffn_conv_w[l], ffn_conv_b[l], ffn_w_down[l])
    return _rmsnorm(x, final_norm_g)
```

```cpp
#include <hip/hip_runtime.h>
#include <cstdio>
#include <cstdint>

#ifndef MK_ONE_LAUNCH
#define MK_ONE_LAUNCH 1
#endif
#ifndef MK_CG_BARRIER
#define MK_CG_BARRIER 0
#endif
#if MK_ONE_LAUNCH && MK_CG_BARRIER
#include <hip/hip_cooperative_groups.h>
namespace cg = cooperative_groups;
#endif

#define LAS __attribute__((address_space(3)))
typedef unsigned short bf16_t;
typedef short bf16x8 __attribute__((ext_vector_type(8)));
typedef float f32x4 __attribute__((ext_vector_type(4)));
typedef float f32x2 __attribute__((ext_vector_type(2)));
typedef unsigned u32x4 __attribute__((ext_vector_type(4)));
typedef unsigned u32x2 __attribute__((ext_vector_type(2)));

constexpr int NB = 8, SEQ = 2048, T = NB * SEQ, D = 1024, NL = 4, FF = 2816;
constexpr int NIN = 2560;
constexpr int NINSRC = 2328;
constexpr int NGU = 2 * FF;
constexpr float EPS = 1e-6f;
constexpr float C2 = 0.125f * 1.4426950408889634f;
constexpr float LOG2E = 1.4426950408889634f;

constexpr size_t MiB = 1u << 20;
constexpr size_t WS_CTL = 0, CTL_ZERO_BYTES = 1 * MiB;
constexpr size_t WS_MOD = 1 * MiB;
constexpr size_t WS_SHW1 = 2 * MiB;
constexpr size_t WS_SHWG = 3 * MiB;
constexpr size_t WS_ROWSS = 4 * MiB;
constexpr size_t WS_SSN = 5 * MiB;
constexpr size_t WS_SSL = 6 * MiB;
constexpr size_t WS_LRUA = WS_SSL;
constexpr size_t WS_GS = 7 * MiB;
constexpr size_t WS_POSB = 7 * MiB + 512 * 1024;
constexpr size_t WS_POSP = 7 * MiB + 576 * 1024;
constexpr size_t WS_KCMP = 8 * MiB;
constexpr size_t WS_FCW = 9 * MiB;
constexpr size_t WS_GFIRST = 10 * MiB, WS_GLAST = 12 * MiB, WS_UFIRST = 14 * MiB;
constexpr size_t WS_ZG = 16 * MiB;
constexpr size_t WS_WTS = 20 * MiB, WTS_LAYER = 27 * MiB;
constexpr size_t WO_WIN = 0, WO_WOUT = 5 * MiB, WO_WGU = 7 * MiB, WO_WDN = 18 * MiB, WO_CW1 = 24 * MiB, WO_CW2 = 26 * MiB, WO_LRUW = 26 * MiB + 256 * 1024;
constexpr size_t WS_XG = 128 * MiB;
constexpr size_t WS_Q = 160 * MiB;
constexpr size_t WS_KV = 176 * MiB, KV_STRIDE = 5 * MiB;
constexpr size_t WS_ZX = 206 * MiB, WS_ZY = 222 * MiB;
constexpr size_t WS_OWIN = 238 * MiB;
constexpr size_t WS_MIXED = 254 * MiB;
constexpr size_t WS_ACT = 160 * MiB;
constexpr size_t WS_XB = 286 * MiB;
constexpr size_t WS_END = 318 * MiB;

constexpr int RING_BYTES = 131072, HALO_OFF = RING_BYTES, HALO_BYTES = 16384, MISC_OFF = HALO_OFF + HALO_BYTES, RSTD_OFF = MISC_OFF + 256, LDS_BYTES = RSTD_OFF + 1024 + 256;

__device__ __forceinline__ float bf2f(unsigned v) { return __uint_as_float(v << 16); }
__device__ __forceinline__ unsigned f2bf(float f) { unsigned u = __float_as_uint(f); return (u + 0x7fffu + ((u >> 16) & 1u)) >> 16; }
__device__ __forceinline__ unsigned pk2(float lo, float hi) { return f2bf(lo) | (f2bf(hi) << 16); }
__device__ __forceinline__ unsigned cvt_pk_bf16(float lo, float hi) { unsigned r; asm volatile("v_cvt_pk_bf16_f32 %0, %1, %2" : "=v"(r) : "v"(lo), "v"(hi)); return r; }
__device__ __forceinline__ void unpack8(const u32x4 v, float* o) {
    o[0] = __uint_as_float(v.x << 16); o[1] = __uint_as_float(v.x & 0xffff0000u); o[2] = __uint_as_float(v.y << 16); o[3] = __uint_as_float(v.y & 0xffff0000u);
    o[4] = __uint_as_float(v.z << 16); o[5] = __uint_as_float(v.z & 0xffff0000u); o[6] = __uint_as_float(v.w << 16); o[7] = __uint_as_float(v.w & 0xffff0000u);
}
__device__ __forceinline__ float sigmoidf_(float x) { return __builtin_amdgcn_rcpf(1.0f + __builtin_amdgcn_exp2f(-1.4426950408889634f * x)); }
__device__ __forceinline__ float siluf_(float x) { return x * __builtin_amdgcn_rcpf(1.0f + __builtin_amdgcn_exp2f(-1.4426950408889634f * x)); }
__device__ __forceinline__ float gelu_tanh(float x) { const float y2 = (2.0f * LOG2E * 0.7978845608028654f) * (x + 0.044715f * x * x * x); return x - x * __builtin_amdgcn_rcpf(1.0f + __builtin_amdgcn_exp2f(y2)); }
__device__ __forceinline__ float wave_sum(float v) {
#pragma unroll
    for (int o = 1; o < 64; o <<= 1) v += __shfl_xor(v, o);
    return v;
}
#define LDS_WAIT() asm volatile("s_waitcnt lgkmcnt(0)" ::: "memory")
__device__ __forceinline__ void st16_wt(void* p, const u32x4 v) { asm volatile("global_store_dwordx4 %0, %1, off sc1\n\ts_nop 1" :: "v"(p), "v"(v) : "memory"); }

namespace pg8 {
constexpr int BM = 256, BK = 64, HALF = 128, HTB = HALF * BK * 2, STAGE_BYTES = 8 * HTB, NXCD = 8, WGM = 4;
__host__ __device__ __forceinline__ int lds_byte(int r, int c) { const int st = (r >> 4) * 2 + (c >> 5), rr = r & 15, cc = c & 31, ob = rr * 64 + cc * 2; return st * 1024 + (ob ^ (((ob >> 9) & 1) << 5)); }
__host__ __device__ __forceinline__ void stage_rc(int b, int& R, int& C) { const int st = b / 1024, sb = b % 1024, swz = sb ^ (((sb >> 9) & 1) << 5); R = (st >> 1) * 16 + swz / 64; C = (st & 1) * 32 + (swz % 64) / 2; }
__host__ __device__ __forceinline__ int perm32(int rho) { const int n = rho >> 4, i = rho & 15; return 8 * (i >> 2) + 4 * n + (i & 3); }
struct Unit { int pm, pn; };
struct Gemm { const bf16_t* A; const bf16_t* Bt; int M, N, K; };
struct StaticOrder {
    int nM, nN, nwg, G, c, wgm;
    __host__ __device__ void init(int M, int N, int G_, int c_, int wgm_ = WGM) { nM = M / BM; nN = N / BM; nwg = nM * nN; G = G_; c = c_; wgm = wgm_; }
    __host__ __device__ bool next(int i, Unit& u) const {
        const long L = (long)i * G + c; if (L >= nwg) return false;
        int wgid = (int)L; { const int q = nwg / NXCD, r = nwg % NXCD, xcd = wgid % NXCD, off = wgid / NXCD; wgid = (xcd < r ? xcd * (q + 1) : r * (q + 1) + (xcd - r) * q) + off; }
        const int nig = wgm * nN, gid = wgid / nig, fm = gid * wgm, gsz = (nM - fm) < wgm ? (nM - fm) : wgm;
        u.pm = fm + ((wgid % nig) % gsz); u.pn = (wgid % nig) / gsz; return true;
    }
};
template <class Epi, class Sched, bool ALIGN_EPI = true, bool SP2 = true>
__device__ __forceinline__ void gemm_phase(LAS unsigned char* lds, LAS unsigned char* ldsx, const Gemm g, const Sched& S, const Epi& E) {
    int tid_ = threadIdx.x; asm volatile("" : "+v"(tid_));
    const int tid = tid_, wid = __builtin_amdgcn_readfirstlane(tid >> 6), lane = tid & 63, wr = wid >> 2, wc = wid & 3, fr = lane & 15, fq = lane >> 4;
    const int K = g.K, nt = K / BK;
    unsigned voffA[2], voffB[2];
#pragma unroll
    for (int i = 0; i < 2; ++i) { int R, C; stage_rc(tid * 16 + i * 8192, R, C); const int Rb = Epi::PERM ? ((R & ~31) + perm32(R & 31)) : R;
        voffA[i] = (unsigned)(R * K + C) * 2u; voffB[i] = (unsigned)(Rb * K + C) * 2u; }
    const size_t kstep = (size_t)(BK * 2);
    const size_t hstep = (size_t)HALF * K * 2;
    const size_t tstep = 2 * hstep;
    const unsigned ldsw = (unsigned)wid * 1024u;
    const int aoff = lds_byte(wr * 64 + fr, fq * 8), boff = lds_byte(wc * 32 + fr, fq * 8);
#define PG8_SA(b, h) (((b) * 2 + (h)) * HTB)
#define PG8_SB(b, h) ((4 + (b) * 2 + (h)) * HTB)
#define PG8_STAGE(bufoff, gbase, voff) do { _Pragma("unroll") for (int _i = 0; _i < 2; ++_i) \
        __builtin_amdgcn_global_load_lds((const unsigned*)((const char*)(gbase) + (voff)[_i]), (LAS unsigned*)(lds + (bufoff) + ldsw + _i * 8192), 16, 0, 0); } while (0)
#define PG8_LDA(dst, b, h) do { _Pragma("unroll") for (int m = 0; m < 4; ++m) _Pragma("unroll") for (int k = 0; k < 2; ++k) dst[m][k] = *(const LAS bf16x8*)(lds + PG8_SA(b, h) + aoff + m * 2048 + k * 1024); } while (0)
#define PG8_LDB(dst, b, h) do { _Pragma("unroll") for (int n = 0; n < 2; ++n) _Pragma("unroll") for (int k = 0; k < 2; ++k) dst[n][k] = *(const LAS bf16x8*)(lds + PG8_SB(b, h) + boff + n * 2048 + k * 1024); } while (0)
#define PG8_MMA(ai, bj, At, Bt) do { __builtin_amdgcn_s_setprio(1); _Pragma("unroll") for (int m = 0; m < 4; ++m) _Pragma("unroll") for (int n = 0; n < 2; ++n) _Pragma("unroll") for (int k = 0; k < 2; ++k) \
        acc[ai][bj][m][n] = __builtin_amdgcn_mfma_f32_16x16x32_bf16(Bt[n][k], At[m][k], acc[ai][bj][m][n], 0, 0, 0); __builtin_amdgcn_s_setprio(0); } while (0)
#define PG8_WAIT_V(n) asm volatile("s_waitcnt vmcnt(" #n ")" ::: "memory")
#define PG8_WAIT_L(n) asm volatile("s_waitcnt lgkmcnt(" #n ")" ::: "memory")
#define PG8_BAR __builtin_amdgcn_s_barrier()
#define PG8_SCHED __builtin_amdgcn_sched_barrier(0)
    Unit cur, nxt; int ui = 0;
    if (!S.next(0, cur)) return;
    f32x4 acc[2][2][4][2];
#pragma unroll
    for (int a = 0; a < 2; ++a)
#pragma unroll
        for (int b = 0; b < 2; ++b)
#pragma unroll
            for (int m = 0; m < 4; ++m)
#pragma unroll
                for (int n = 0; n < 2; ++n) acc[a][b][m][n] = (f32x4){0.f, 0.f, 0.f, 0.f};
    bf16x8 At[4][2], B0[2][2], B1[2][2];
    const char* cA = (const char*)g.A + (size_t)cur.pm * tstep; const char* cB = (const char*)g.Bt + (size_t)cur.pn * tstep;
    typename Epi::PreRegs pregs;
    if constexpr (Epi::PRE) E.pre_issue(pregs, cur.pm, wid, lane);
    if constexpr (SP2) {
        PG8_STAGE(PG8_SB(0, 0), cB, voffB); PG8_STAGE(PG8_SB(0, 1), cB + hstep, voffB); PG8_STAGE(PG8_SA(0, 0), cA, voffA); PG8_STAGE(PG8_SA(0, 1), cA + hstep, voffA);
        if (wr == 1) PG8_BAR;
        PG8_WAIT_V(2); PG8_BAR;
        if constexpr (Epi::PRE) E.pre_commit(pregs, ldsx, wid, lane);
        PG8_STAGE(PG8_SB(1, 0), cB + kstep, voffB); PG8_STAGE(PG8_SA(1, 0), cA + kstep, voffA); PG8_STAGE(PG8_SB(1, 1), cB + hstep + kstep, voffB);
        PG8_WAIT_V(6); PG8_BAR;
    } else {
        PG8_STAGE(PG8_SB(0, 0), cB, voffB); PG8_STAGE(PG8_SA(0, 0), cA, voffA); PG8_STAGE(PG8_SB(0, 1), cB + hstep, voffB); PG8_STAGE(PG8_SA(0, 1), cA + hstep, voffA);
        if (wr == 1) PG8_BAR;
        PG8_WAIT_V(4); PG8_BAR;
        if constexpr (Epi::PRE) E.pre_commit(pregs, ldsx, wid, lane);
        PG8_STAGE(PG8_SB(1, 0), cB + kstep, voffB); PG8_STAGE(PG8_SA(1, 0), cA + kstep, voffA); PG8_STAGE(PG8_SB(1, 1), cB + hstep + kstep, voffB);
        PG8_WAIT_V(6); PG8_BAR;
    }
    for (;;) {
        const bool has_next = S.next(ui + 1, nxt);
        const char* nA = has_next ? (const char*)g.A + (size_t)nxt.pm * tstep : cA; const char* nB = has_next ? (const char*)g.Bt + (size_t)nxt.pn * tstep : cB;
        for (int t = 0; t < nt; t += 2) {
            const bool last = (t == nt - 2);
            const char* a1 = cA + (size_t)(t + 1) * kstep;
            const char* a2 = last ? nA : cA + (size_t)(t + 2) * kstep; const char* b2 = last ? nB : cB + (size_t)(t + 2) * kstep;
            const char* a3 = a2 + kstep; const char* b3 = b2 + kstep;
            if constexpr (Epi::MIDK) { if (t == (nt >> 1)) E.midk(acc, cur, wr, fr, ldsx); }
            if constexpr (SP2) {
            PG8_LDB(B0, 0, 0); PG8_LDB(B1, 0, 1); PG8_SCHED; PG8_LDA(At, 0, 0); PG8_STAGE(PG8_SA(1, 1), a1 + hstep, voffA);
            PG8_WAIT_V(8); PG8_WAIT_L(0); PG8_BAR; PG8_MMA(0, 0, At, B0); PG8_MMA(0, 1, At, B1); PG8_BAR; PG8_SCHED;
            PG8_LDA(At, 0, 1); PG8_STAGE(PG8_SB(0, 0), b2, voffB); PG8_STAGE(PG8_SB(0, 1), b2 + hstep, voffB); PG8_STAGE(PG8_SA(0, 0), a2, voffA);
            PG8_WAIT_V(8); PG8_WAIT_L(0); PG8_BAR; PG8_MMA(1, 0, At, B0); PG8_MMA(1, 1, At, B1); PG8_BAR; PG8_SCHED;
            PG8_LDB(B0, 1, 0); PG8_LDB(B1, 1, 1); PG8_SCHED; PG8_LDA(At, 1, 0); PG8_STAGE(PG8_SA(0, 1), a2 + hstep, voffA);
            PG8_WAIT_V(8); PG8_WAIT_L(0); PG8_BAR; PG8_MMA(0, 0, At, B0); PG8_MMA(0, 1, At, B1); PG8_BAR; PG8_SCHED;
            PG8_LDA(At, 1, 1); PG8_STAGE(PG8_SB(1, 0), b3, voffB); PG8_STAGE(PG8_SB(1, 1), b3 + hstep, voffB); PG8_STAGE(PG8_SA(1, 0), a3, voffA);
            PG8_WAIT_V(8); PG8_WAIT_L(0); PG8_BAR; PG8_MMA(1, 0, At, B0); PG8_MMA(1, 1, At, B1); PG8_BAR; PG8_SCHED;
            } else {
            PG8_LDB(B0, 0, 0); PG8_SCHED; PG8_LDA(At, 0, 0); PG8_STAGE(PG8_SA(1, 1), a1 + hstep, voffA);
            PG8_WAIT_L(8); PG8_BAR; PG8_WAIT_L(0); PG8_MMA(0, 0, At, B0); PG8_BAR; PG8_SCHED;
            PG8_LDB(B1, 0, 1); PG8_STAGE(PG8_SB(0, 0), b2, voffB);
            PG8_BAR; PG8_WAIT_L(0); PG8_MMA(0, 1, At, B1); PG8_BAR;
            PG8_LDA(At, 0, 1); PG8_STAGE(PG8_SA(0, 0), a2, voffA);
            PG8_BAR; PG8_WAIT_L(0); PG8_MMA(1, 0, At, B0); PG8_BAR; PG8_SCHED;
            PG8_STAGE(PG8_SB(0, 1), b2 + hstep, voffB);
            PG8_WAIT_V(6); PG8_BAR; PG8_MMA(1, 1, At, B1); PG8_BAR;
            PG8_LDB(B0, 1, 0); PG8_SCHED; PG8_LDA(At, 1, 0); PG8_STAGE(PG8_SA(0, 1), a2 + hstep, voffA);
            PG8_WAIT_L(8); PG8_BAR; PG8_WAIT_L(0); PG8_MMA(0, 0, At, B0); PG8_BAR; PG8_SCHED;
            PG8_LDB(B1, 1, 1); PG8_STAGE(PG8_SB(1, 0), b3, voffB);
            PG8_BAR; PG8_WAIT_L(0); PG8_MMA(0, 1, At, B1); PG8_BAR;
            PG8_LDA(At, 1, 1); PG8_STAGE(PG8_SA(1, 0), a3, voffA);
            PG8_BAR; PG8_WAIT_L(0); PG8_MMA(1, 0, At, B0); PG8_BAR; PG8_SCHED;
            PG8_STAGE(PG8_SB(1, 1), b3 + hstep, voffB);
            PG8_WAIT_V(6); PG8_BAR; PG8_MMA(1, 1, At, B1); PG8_BAR;
            }
        }
        if constexpr (ALIGN_EPI) { if (wr == 0) PG8_BAR; }
        E(acc, cur, wr, wc, fr, fq, ldsx, wid, lane, ui & 1, has_next ? nxt.pm : -1);
        if (!has_next) break;
#pragma unroll
        for (int a = 0; a < 2; ++a)
#pragma unroll
            for (int b = 0; b < 2; ++b)
#pragma unroll
                for (int m = 0; m < 4; ++m)
#pragma unroll
                    for (int n = 0; n < 2; ++n) acc[a][b][m][n] = (f32x4){0.f, 0.f, 0.f, 0.f};
        cur = nxt; cA = nA; cB = nB; ++ui;
        if constexpr (ALIGN_EPI) { if (wr == 1) PG8_BAR; }
    }
    PG8_WAIT_V(0);
    if constexpr (!ALIGN_EPI) { if (wr == 0) PG8_BAR; }
    PG8_BAR;
#undef PG8_SA
#undef PG8_SB
#undef PG8_STAGE
#undef PG8_LDA
#undef PG8_LDB
#undef PG8_MMA
#undef PG8_WAIT_V
#undef PG8_WAIT_L
#undef PG8_BAR
#undef PG8_SCHED
}
}

__device__ __forceinline__ float row_rstd(const float* rowss, int row, int fq) {
    const f32x4 p = *(const f32x4*)(rowss + (size_t)row * 16 + fq * 4);
    float s = (p.x + p.y) + (p.z + p.w);
    s += __shfl_xor(s, 16); s += __shfl_xor(s, 32);
    return rsqrtf(s * (1.0f / D) + EPS);
}

struct RstdAhead { f32x4 v0, v1; };
__device__ __forceinline__ void rstd_issue(RstdAhead& r, const float* rowss, int pm, int tid) {
    const float* p = rowss + ((size_t)pm * 256 + (tid >> 2)) * 16 + (tid & 3) * 4; r.v0 = *(const f32x4*)p; r.v1 = *(const f32x4*)(p + 128 * 16);
}
__device__ __forceinline__ void rstd_commit(const RstdAhead& r, LAS float* tab, int tid) {
    float s0 = (r.v0.x + r.v0.y) + (r.v0.z + r.v0.w), s1 = (r.v1.x + r.v1.y) + (r.v1.z + r.v1.w);
    s0 += __shfl_xor(s0, 1); s1 += __shfl_xor(s1, 1); s0 += __shfl_xor(s0, 2); s1 += __shfl_xor(s1, 2);
    if ((tid & 3) == 0) { tab[tid >> 2] = rsqrtf(s0 * (1.0f / D) + EPS); tab[128 + (tid >> 2)] = rsqrtf(s1 * (1.0f / D) + EPS); }
}
__device__ __forceinline__ void rstd_pre(const float* rowss, int pm, LAS unsigned char* ldsx, int wid, int lane) {
    RstdAhead r; rstd_issue(r, rowss, pm, wid * 64 + lane); rstd_commit(r, (LAS float*)(ldsx + 4096), wid * 64 + lane);
    LDS_WAIT(); __builtin_amdgcn_s_barrier(); asm volatile("" ::: "memory");
}
__device__ __forceinline__ LAS float* rstd_table(const float* rowss, int pm, LAS unsigned char* ldsx, int wid, int lane) {
    LAS float* tab = (LAS float*)(ldsx + (RSTD_OFF - HALO_OFF));
    if (wid < 4) { const int r = wid * 64 + lane; const f32x4* p = (const f32x4*)(rowss + ((size_t)pm * 256 + r) * 16); const f32x4 a = p[0], b = p[1], c = p[2], d = p[3];
        const float sm = ((a.x + a.y) + (a.z + a.w)) + ((b.x + b.y) + (b.z + b.w)) + ((c.x + c.y) + (c.z + c.w)) + ((d.x + d.y) + (d.z + d.w));
        tab[r] = rsqrtf(sm * (1.0f / D) + EPS); }
    LDS_WAIT(); __builtin_amdgcn_s_barrier(); asm volatile("" ::: "memory");
    return tab;
}

struct EpiIn {
    static constexpr bool PERM = true, MIDK = false, PRE = true;
    unsigned char* ws; int l;
    typedef RstdAhead PreRegs;
    __device__ __forceinline__ void pre_issue(PreRegs& r, int pm, int wid, int lane) const { rstd_issue(r, (const float*)(ws + WS_ROWSS), pm, wid * 64 + lane); }
    __device__ __forceinline__ void pre_commit(const PreRegs& r, LAS unsigned char* ldsx, int wid, int lane) const { rstd_commit(r, (LAS float*)(ldsx + 4096), wid * 64 + lane); }
    __device__ __forceinline__ void operator()(const f32x4 (&acc)[2][2][4][2], const pg8::Unit& u, int wr, int wc, int fr, int fq, LAS unsigned char* ldsx, int wid, int lane, int par, int nxt_pm) const {
        asm volatile("" : "+v"(fr), "+v"(fq), "+v"(lane));
        RstdAhead ra; if (nxt_pm >= 0) rstd_issue(ra, (const float*)(ws + WS_ROWSS), nxt_pm, wid * 64 + lane);
        const float* shw = (const float*)(ws + WS_SHW1) + (size_t)l * NB * NIN; bf16_t* Q = (bf16_t*)(ws + WS_Q); bf16_t* KV = (bf16_t*)(ws + WS_KV);
        bf16_t* ZX = (bf16_t*)(ws + WS_ZX); bf16_t* ZY = (bf16_t*)(ws + WS_ZY); float* ZG = (float*)(ws + WS_ZG);
        const int b = u.pm >> 3, cin = wc * 32 + 8 * fq, row0 = u.pm * 256 + wr * 64 + fr;
        f32x4 bv[2][2];
#pragma unroll
        for (int bj = 0; bj < 2; ++bj)
#pragma unroll
            for (int n = 0; n < 2; ++n) bv[bj][n] = *(const f32x4*)(shw + b * NIN + u.pn * 256 + bj * 128 + cin + 4 * n);
        const LAS float* rtab = (const LAS float*)(ldsx + 4096 + 1024 * par);
#pragma unroll
        for (int ai = 0; ai < 2; ++ai)
#pragma unroll
            for (int m = 0; m < 4; ++m) {
                const int row = row0 + ai * 128 + m * 16;
                const float rs = rtab[ai * 128 + wr * 64 + m * 16 + fr];
#pragma unroll
                for (int bj = 0; bj < 2; ++bj) {
                    f32x4 v0 = acc[ai][bj][m][0] * rs + bv[bj][0], v1 = acc[ai][bj][m][1] * rs + bv[bj][1];
                    const int col = u.pn * 256 + bj * 128 + cin;
                    if (u.pn < 2) { v0 = v0 * C2; v1 = v1 * C2; }
                    u32x4 w; w.x = cvt_pk_bf16(v0[0], v0[1]); w.y = cvt_pk_bf16(v0[2], v0[3]); w.z = cvt_pk_bf16(v1[0], v1[1]); w.w = cvt_pk_bf16(v1[2], v1[3]);
                    if (u.pn < 2) st16_wt(Q + (size_t)row * 512 + col, w);
                    else if (u.pn < 5) { const int c2 = col - 512, arr = c2 >> 7, wi = c2 & 127, g = wi >> 6, d = wi & 63, t = row & (SEQ - 1);
                        st16_wt(KV + (size_t)arr * (KV_STRIDE / 2) + ((size_t)((b * 2 + g) * SEQ + t) * 64 + d), w); }
                    else if (u.pn < 7) st16_wt(ZX + (size_t)row * 512 + (col - 1280), w);
                    else if (u.pn < 9) st16_wt(ZY + (size_t)row * 512 + (col - 1792), w);
                    else { const int c = col - 2304; if (c < 24) { *(f32x4*)(ZG + (size_t)row * 24 + c) = v0; *(f32x4*)(ZG + (size_t)row * 24 + c + 4) = v1; } }
                }
            }
        if (nxt_pm >= 0) rstd_commit(ra, (LAS float*)(ldsx + 4096 + 1024 * (par ^ 1)), wid * 64 + lane);
    }
};

template <bool MIDK_, bool BF32> struct EpiRes {
    static constexpr bool PERM = true, MIDK = MIDK_, PRE = MIDK_;
    struct PreRegs { f32x2 sn; f32x4 a, b, c, d; };
    __device__ __forceinline__ void pre_issue(PreRegs& r, int pm, int wid, int lane) const { const int t = wid * 64 + lane; const size_t row = (size_t)pm * 256 + (t & 255);
        r.sn = *(const f32x2*)((const float*)(ws + WS_SSN) + row * 2); const f32x4* pl = (const f32x4*)((const float*)(ws + WS_SSL) + row * 16); r.a = pl[0]; r.b = pl[1]; r.c = pl[2]; r.d = pl[3]; }
    __device__ __forceinline__ void pre_commit(const PreRegs& r, LAS unsigned char* ldsx, int wid, int lane) const { const int t = wid * 64 + lane;
        const float sl = ((r.a.x + r.a.y) + (r.a.z + r.a.w)) + ((r.b.x + r.b.y) + (r.b.z + r.b.w)) + ((r.c.x + r.c.y) + (r.c.z + r.c.w)) + ((r.d.x + r.d.y) + (r.d.z + r.d.w));
        const float rn = rsqrtf((r.sn.x + r.sn.y) * (1.0f / 512.0f) + EPS), rl = rsqrtf(sl * (1.0f / 512.0f) + EPS);
        if (t < 256) ((LAS f32x2*)ldsx)[t] = (f32x2){rn / rl, rl}; }
    const void* base; unsigned char* ws; int goff; int gsoff; int dry;
    __device__ __forceinline__ void midk(f32x4 (&acc)[2][2][4][2], const pg8::Unit& u, int wr, int fr, LAS unsigned char* ldsx) const {
        asm volatile("" : "+v"(fr));
        const LAS f32x2* rs2 = (const LAS f32x2*)ldsx;
#pragma unroll
        for (int ai = 0; ai < 2; ++ai)
#pragma unroll
            for (int m = 0; m < 4; ++m) { const float s = rs2[ai * 128 + wr * 64 + m * 16 + fr].x;
#pragma unroll
                for (int bj = 0; bj < 2; ++bj)
#pragma unroll
                    for (int n = 0; n < 2; ++n) acc[ai][bj][m][n] = acc[ai][bj][m][n] * s; }
    }
    __device__ __forceinline__ void operator()(const f32x4 (&acc)[2][2][4][2], const pg8::Unit& u, int wr, int wc, int fr, int fq, LAS unsigned char* ldsx, int, int, int, int) const {
        run(acc, u, wr, wc, fr, fq, ldsx, dry);
#if REP_SUB == 7
        run(acc, u, wr, wc, fr, fq, ldsx, MIDK ? 1 : 2);
#endif
    }
    __device__ __forceinline__ void run(const f32x4 (&acc)[2][2][4][2], const pg8::Unit& u, int wr, int wc, int fr, int fq, LAS unsigned char* ldsx, int dry) const {
        asm volatile("" : "+v"(fr), "+v"(fq));
        const LAS f32x2* rs2 = (const LAS f32x2*)ldsx;
        const float* gate = (const float*)(ws + WS_MOD) + goff; const float* gsn = (const float*)(ws + WS_GS) + gsoff;
        bf16_t* XG = (bf16_t*)(ws + (dry ? (dry == 1 ? WS_ZX : WS_MIXED) : WS_XG)); bf16_t* XB = (bf16_t*)(ws + (dry ? (dry == 1 ? WS_Q : WS_MIXED) : WS_XB)); float* rowss = (float*)(ws + (dry ? WS_LRUA : WS_ROWSS));
        const float* basef = (const float*)base; const bf16_t* baseb = (const bf16_t*)base;
        const int b = u.pm >> 3, col0 = u.pn * 256 + wc * 32 + 8 * fq;
        f32x4 gv[2][2], gs[2][2];
#pragma unroll
        for (int bj = 0; bj < 2; ++bj)
#pragma unroll
            for (int n = 0; n < 2; ++n) { gv[bj][n] = *(const f32x4*)(gate + (size_t)b * 6144 + col0 + bj * 128 + n * 4); gs[bj][n] = *(const f32x4*)(gsn + (size_t)b * D + col0 + bj * 128 + n * 4); }
        f32x4 pre[2][2][2]; u32x4 prb[4][2];
        {   const size_t off0 = (size_t)(u.pm * 256 + wr * 64 + fr) * D + col0;
            if constexpr (BF32) {
#pragma unroll
                for (int bj = 0; bj < 2; ++bj) { pre[0][bj][0] = *(const f32x4*)(basef + off0 + bj * 128); pre[0][bj][1] = *(const f32x4*)(basef + off0 + bj * 128 + 4); }
            } else {
#pragma unroll
                for (int g8 = 0; g8 < 4; ++g8)
#pragma unroll
                    for (int bj = 0; bj < 2; ++bj) prb[g8][bj] = *(const u32x4*)(baseb + off0 + (size_t)(g8 * 16) * D + bj * 128);
            } }
#pragma unroll
        for (int gi = 0; gi < 8; ++gi) {
            const int ai = gi >> 2, m = gi & 3;
            const int row = u.pm * 256 + ai * 128 + wr * 64 + m * 16 + fr; const size_t off = (size_t)row * D + col0; float ss = 0.f;
            const float rl = MIDK ? rs2[ai * 128 + wr * 64 + m * 16 + fr].y : 1.0f;
            if constexpr (BF32) { if (gi < 7) { const int ai2 = (gi + 1) >> 2, m2 = (gi + 1) & 3; const size_t off2 = (size_t)(u.pm * 256 + ai2 * 128 + wr * 64 + m2 * 16 + fr) * D + col0;
#pragma unroll
                for (int bj = 0; bj < 2; ++bj) { pre[(gi + 1) & 1][bj][0] = *(const f32x4*)(basef + off2 + bj * 128); pre[(gi + 1) & 1][bj][1] = *(const f32x4*)(basef + off2 + bj * 128 + 4); } } }
#pragma unroll
            for (int bj = 0; bj < 2; ++bj) {
                f32x4 r0, r1;
                if constexpr (BF32) { r0 = pre[gi & 1][bj][0]; r1 = pre[gi & 1][bj][1]; }
                else { const u32x4 v = prb[gi & 3][bj]; r0 = (f32x4){__uint_as_float(v.x << 16), __uint_as_float(v.x & 0xffff0000u), __uint_as_float(v.y << 16), __uint_as_float(v.y & 0xffff0000u)};
                    r1 = (f32x4){__uint_as_float(v.z << 16), __uint_as_float(v.z & 0xffff0000u), __uint_as_float(v.w << 16), __uint_as_float(v.w & 0xffff0000u)};
                    if (gi < 4) prb[gi & 3][bj] = *(const u32x4*)(baseb + (size_t)(u.pm * 256 + 128 + wr * 64 + gi * 16 + fr) * D + col0 + bj * 128); }
                const f32x4 x0 = r0 + gv[bj][0] * (MIDK ? acc[ai][bj][m][0] * rl : acc[ai][bj][m][0]), x1 = r1 + gv[bj][1] * (MIDK ? acc[ai][bj][m][1] * rl : acc[ai][bj][m][1]);
                ss += ((x0[0] * x0[0] + x0[1] * x0[1]) + (x0[2] * x0[2] + x0[3] * x0[3])) + ((x1[0] * x1[0] + x1[1] * x1[1]) + (x1[2] * x1[2] + x1[3] * x1[3]));
                u32x4 w; w.x = cvt_pk_bf16(x0[0], x0[1]); w.y = cvt_pk_bf16(x0[2], x0[3]); w.z = cvt_pk_bf16(x1[0], x1[1]); w.w = cvt_pk_bf16(x1[2], x1[3]);
                *(u32x4*)(XB + off + bj * 128) = w;
                const f32x4 y0 = x0 * gs[bj][0], y1 = x1 * gs[bj][1];
                u32x4 wg; wg.x = cvt_pk_bf16(y0[0], y0[1]); wg.y = cvt_pk_bf16(y0[2], y0[3]); wg.z = cvt_pk_bf16(y1[0], y1[1]); wg.w = cvt_pk_bf16(y1[2], y1[3]);
                *(u32x4*)(XG + off + bj * 128) = wg; }
            ss += __shfl_xor(ss, 16); ss += __shfl_xor(ss, 32);
            if (fq == 0) rowss[(size_t)row * 16 + u.pn * 4 + wc] = ss;
            asm volatile("" ::: "memory");
        }
    }
};

constexpr int CW_PANEL = 9216;
struct EpiFinal {
    static constexpr bool PERM = false, MIDK = false, PRE = false;
    struct PreRegs {};
    const bf16_t* base; float* out; unsigned char* ws; int goff; const float* fg;
    __device__ __forceinline__ void operator()(f32x4 (&acc)[2][2][4][2], const pg8::Unit& u, int wr, int wc, int fr, int fq, LAS unsigned char* ldsx, int wid, int lane, int, int) const {
        asm volatile("" : "+v"(fr), "+v"(fq), "+v"(lane));
        const float* gate = (const float*)(ws + WS_MOD) + goff; float* rowss = (float*)(ws + WS_ROWSS); unsigned* pcnt = (unsigned*)(ws + WS_CTL) + CW_PANEL + 64 * u.pm;
        const int b = u.pm >> 3, col0 = u.pn * 256 + wc * 32 + 4 * fq;
        {   f32x4 gv[2][2];
#pragma unroll
            for (int bj = 0; bj < 2; ++bj)
#pragma unroll
                for (int n = 0; n < 2; ++n) gv[bj][n] = *(const f32x4*)(gate + (size_t)b * 6144 + col0 + bj * 128 + n * 16);
            u32x2 pre[2][2][2];
#pragma unroll
            for (int bj = 0; bj < 2; ++bj)
#pragma unroll
                for (int n = 0; n < 2; ++n) pre[0][bj][n] = *(const u32x2*)(base + (size_t)(u.pm * 256 + wr * 64 + fr) * D + col0 + bj * 128 + n * 16);
#pragma unroll
            for (int gi = 0; gi < 8; ++gi) {
                const int ai = gi >> 2, m = gi & 3; const int row = u.pm * 256 + ai * 128 + wr * 64 + m * 16 + fr; float ss = 0.f;
                if (gi < 7) { const int ai2 = (gi + 1) >> 2, m2 = (gi + 1) & 3; const size_t off2 = (size_t)(u.pm * 256 + ai2 * 128 + wr * 64 + m2 * 16 + fr) * D + col0;
#pragma unroll
                    for (int bj = 0; bj < 2; ++bj)
#pragma unroll
                        for (int n = 0; n < 2; ++n) pre[(gi + 1) & 1][bj][n] = *(const u32x2*)(base + off2 + bj * 128 + n * 16); }
#pragma unroll
                for (int bj = 0; bj < 2; ++bj)
#pragma unroll
                    for (int n = 0; n < 2; ++n) { const u32x2 v = pre[gi & 1][bj][n]; const f32x4 r = (f32x4){__uint_as_float(v.x << 16), __uint_as_float(v.x & 0xffff0000u), __uint_as_float(v.y << 16), __uint_as_float(v.y & 0xffff0000u)};
                        const f32x4 x = r + gv[bj][n] * acc[ai][bj][m][n]; acc[ai][bj][m][n] = x; ss += (x[0] * x[0] + x[1] * x[1]) + (x[2] * x[2] + x[3] * x[3]); }
                ss += __shfl_xor(ss, 16); ss += __shfl_xor(ss, 32);
                if (fq == 0) rowss[(size_t)row * 16 + u.pn * 4 + wc] = ss;
                asm volatile("" ::: "memory");
            }
        }
        asm volatile("s_waitcnt vmcnt(0)" ::: "memory"); __builtin_amdgcn_s_barrier(); asm volatile("" ::: "memory");
        if (wid == 0 && lane == 0) {
            __builtin_amdgcn_fence(__ATOMIC_RELEASE, "agent"); asm volatile("s_waitcnt vmcnt(0)" ::: "memory");
            __hip_atomic_fetch_add(pcnt, 1u, __ATOMIC_RELAXED, __HIP_MEMORY_SCOPE_AGENT);
            unsigned sp = 0; while (__hip_atomic_load(pcnt, __ATOMIC_RELAXED, __HIP_MEMORY_SCOPE_AGENT) < 4u) { __builtin_amdgcn_s_sleep(1); if (++sp > (1u << 22)) break; }
            __builtin_amdgcn_fence(__ATOMIC_ACQUIRE, "agent"); asm volatile("s_waitcnt vmcnt(0)" ::: "memory"); }
        __builtin_amdgcn_s_barrier(); asm volatile("" ::: "memory");
        const LAS float* rtab = rstd_table(rowss, u.pm, ldsx, wid, lane);
        f32x4 fgv[2][2];
#pragma unroll
        for (int bj = 0; bj < 2; ++bj)
#pragma unroll
            for (int n = 0; n < 2; ++n) fgv[bj][n] = *(const f32x4*)(fg + col0 + bj * 128 + n * 16);
#pragma unroll
        for (int ai = 0; ai < 2; ++ai)
#pragma unroll
            for (int m = 0; m < 4; ++m) { const int rl_ = ai * 128 + wr * 64 + m * 16 + fr; const float rs = rtab[rl_]; const size_t off = (size_t)(u.pm * 256 + rl_) * D + col0;
#pragma unroll
                for (int bj = 0; bj < 2; ++bj)
#pragma unroll
                    for (int n = 0; n < 2; ++n) { const f32x4 y = acc[ai][bj][m][n] * rs * fgv[bj][n]; st16_wt(out + off + bj * 128 + n * 16, __builtin_bit_cast(u32x4, y)); } }
    }
};

struct EpiGU {
    static constexpr bool PERM = true, MIDK = false, PRE = true;
    unsigned char* ws; int l;
    typedef RstdAhead PreRegs;
    __device__ __forceinline__ void pre_issue(PreRegs& r, int pm, int wid, int lane) const { rstd_issue(r, (const float*)(ws + WS_ROWSS), pm, wid * 64 + lane); }
    __device__ __forceinline__ void pre_commit(const PreRegs& r, LAS unsigned char* ldsx, int wid, int lane) const { rstd_commit(r, (LAS float*)(ldsx + 4096), wid * 64 + lane); }
    static __device__ __forceinline__ float dpp_shr1(float old, float v) { return __int_as_float(__builtin_amdgcn_update_dpp(__float_as_int(old), __float_as_int(v), 0x111, 0xf, 0xf, false)); }
    static __device__ __forceinline__ float dpp_shr2(float old, float v) { return __int_as_float(__builtin_amdgcn_update_dpp(__float_as_int(old), __float_as_int(v), 0x112, 0xf, 0xf, false)); }
    static __device__ __forceinline__ float dpp_ror1(float v) { return __int_as_float(__builtin_amdgcn_update_dpp(0, __float_as_int(v), 0x121, 0xf, 0xf, true)); }
    static __device__ __forceinline__ float dpp_ror2(float v) { return __int_as_float(__builtin_amdgcn_update_dpp(0, __float_as_int(v), 0x122, 0xf, 0xf, true)); }
    __device__ __forceinline__ void operator()(f32x4 (&acc)[2][2][4][2], const pg8::Unit& u, int wr, int wc, int fr, int fq, LAS unsigned char* ldsx, int wid, int lane, int par, int nxt_pm) const {
        asm volatile("" : "+v"(fr), "+v"(fq), "+v"(lane)); asm volatile("" : "+s"(wr), "+s"(wc));
        RstdAhead ra; if (nxt_pm >= 0) rstd_issue(ra, (const float*)(ws + WS_ROWSS), nxt_pm, wid * 64 + lane);
        const float* shw = (const float*)(ws + WS_SHWG) + (size_t)l * NB * NGU; const float* cw = (const float*)(ws + WS_FCW) + (size_t)l * 4 * FF; const float* cb = cw + 3 * FF;
        bf16_t* ACT = (bf16_t*)(ws + WS_ACT); float* gfirst = (float*)(ws + WS_GFIRST); float* glast = (float*)(ws + WS_GLAST); float* ufirst = (float*)(ws + WS_UFIRST);
        const int b = u.pm >> 3, cin = wc * 32 + 8 * fq, colg = u.pn * 128 + cin;
        f32x4 bgv[2], buv[2], w0v[2], w1v[2], w2v[2], cbvv[2];
#pragma unroll
        for (int n = 0; n < 2; ++n) { bgv[n] = *(const f32x4*)(shw + (size_t)b * NGU + u.pn * 256 + cin + 4 * n); buv[n] = *(const f32x4*)(shw + (size_t)b * NGU + u.pn * 256 + 128 + cin + 4 * n);
            w0v[n] = *(const f32x4*)(cw + colg + 4 * n); w1v[n] = *(const f32x4*)(cw + FF + colg + 4 * n); w2v[n] = *(const f32x4*)(cw + 2 * FF + colg + 4 * n); cbvv[n] = *(const f32x4*)(cb + colg + 4 * n); }
        const LAS float* rtab = (const LAS float*)(ldsx + 4096 + 1024 * par);
        LAS float* halo = (LAS float*)ldsx;
#pragma unroll
        for (int ai = 0; ai < 2; ++ai)
#pragma unroll
            for (int m = 0; m < 4; ++m) { const float rs = rtab[ai * 128 + wr * 64 + m * 16 + fr];
#pragma unroll
                for (int n = 0; n < 2; ++n) { acc[ai][0][m][n] = acc[ai][0][m][n] * rs + bgv[n]; acc[ai][1][m][n] = acc[ai][1][m][n] * rs + buv[n]; }
                if (m == 3) { if (fr >= 14) {
#pragma unroll
                    for (int n = 0; n < 2; ++n) *(LAS f32x4*)(halo + ((ai * 2 + wr) * 2 + (fr - 14)) * 128 + cin + 4 * n) = acc[ai][0][3][n]; } } }
        LDS_WAIT(); __builtin_amdgcn_s_barrier(); asm volatile("" ::: "memory");
        const bool f0 = fr == 0, f01 = fr < 2;
#pragma unroll
        for (int ai = 0; ai < 2; ++ai)
#pragma unroll
            for (int m = 0; m < 4; ++m) {
                const size_t row = (size_t)u.pm * 256 + ai * 128 + wr * 64 + m * 16 + fr;
                u32x4 wout;
#pragma unroll
                for (int n = 0; n < 2; ++n) {
                    const f32x4 w0 = w0v[n], w1 = w1v[n], w2 = w2v[n], cbv = cbvv[n];
                    const f32x4 g0 = acc[ai][0][m][n]; f32x4 g1, g2;
                    if (m > 0) { const f32x4 P = acc[ai][0][m > 0 ? m - 1 : 0][n];
#pragma unroll
                        for (int j = 0; j < 4; ++j) { g1[j] = dpp_shr1(dpp_ror1(P[j]), g0[j]); g2[j] = dpp_shr2(dpp_ror2(P[j]), g0[j]); } }
                    else { const int slot = wr == 1 ? ai * 2 : (ai == 1 ? 1 : 0);
                        const f32x4 p14 = *(const LAS f32x4*)(halo + (slot * 2 + 0) * 128 + cin + 4 * n), p15 = *(const LAS f32x4*)(halo + (slot * 2 + 1) * 128 + cin + 4 * n);
#pragma unroll
                        for (int j = 0; j < 4; ++j) { g1[j] = dpp_shr1(p15[j], g0[j]); g2[j] = dpp_shr2(f0 ? p14[j] : p15[j], g0[j]); } }
                    const f32x4 cv = cbv + w0 * g2 + w1 * g1 + w2 * g0, up = acc[ai][1][m][n];
                    if (ai == 0 && m == 0) { if (wr == 0 && f01) { *(f32x4*)(gfirst + ((size_t)u.pm * 2 + fr) * FF + colg + 4 * n) = g0; *(f32x4*)(ufirst + ((size_t)u.pm * 2 + fr) * FF + colg + 4 * n) = up; } }
                    if (ai == 1 && m == 3) { if (wr == 1 && fr >= 14) *(f32x4*)(glast + ((size_t)u.pm * 2 + (fr - 14)) * FF + colg + 4 * n) = g0; }
                    const float r0 = siluf_(cv[0]) * up[0], r1 = siluf_(cv[1]) * up[1], r2 = siluf_(cv[2]) * up[2], r3 = siluf_(cv[3]) * up[3];
                    if (n == 0) { wout.x = cvt_pk_bf16(r0, r1); wout.y = cvt_pk_bf16(r2, r3); } else { wout.z = cvt_pk_bf16(r0, r1); wout.w = cvt_pk_bf16(r2, r3); }
                }
                if (ai == 0 && m == 0) { if (!(wr == 0 && f01)) st16_wt(ACT + row * FF + colg, wout); }
                else st16_wt(ACT + row * FF + colg, wout);
            }
        if (nxt_pm >= 0) rstd_commit(ra, (LAS float*)(ldsx + 4096 + 1024 * (par ^ 1)), wid * 64 + lane);
    }
};

#define XB_TMO      128
#define XB_XCNT(j)  (256  + 64 * (j))
#define XB_XSUB(j)  (1280 + 64 * (j))
#define XB_XGEN(j)  (2304 + 64 * (j))
#define XB_TOP      3328
#define XB_TOPGEN   3392
#define XCD_BAR_WORDS 3456
#define XB_SPIN_CAP (1u << 18)
__device__ __forceinline__ unsigned xb_ld(unsigned* p)              { return __hip_atomic_load(p, __ATOMIC_RELAXED, __HIP_MEMORY_SCOPE_AGENT); }
__device__ __forceinline__ unsigned xb_add(unsigned* p, unsigned v) { return __hip_atomic_fetch_add(p, v, __ATOMIC_RELAXED, __HIP_MEMORY_SCOPE_AGENT); }
__device__ __forceinline__ unsigned xb_xcc_id() { return (unsigned)__builtin_amdgcn_s_getreg((3 << 11) | 20) & 0xFu; }
#define XB_SPIN(cond, bar) do { unsigned _sp = 0; while (cond) { __builtin_amdgcn_s_sleep(1); \
    if ((++_sp & 255u) == 0u) { if (xb_ld(&(bar)[XB_TMO])) break; if (_sp > XB_SPIN_CAP) { atomicAdd(&(bar)[XB_TMO], 1u); break; } } } } while (0)
__device__ __forceinline__ void xcd_barrier_complete(unsigned* bar, unsigned x, unsigned& nloc, unsigned& nx) {
    const unsigned G = gridDim.x * gridDim.y * gridDim.z;
    unsigned sum, cnt, mine, sp = 0u;
    for (;;) {
        sum = 0u; cnt = 0u; mine = 0u;
#pragma unroll
        for (unsigned j = 0; j < 16; ++j) { const unsigned c = xb_ld(&bar[XB_XCNT(j)]); sum += c; cnt += (c > 0u) ? 1u : 0u; mine = (j == x) ? c : mine; }
        if (sum == G) break;
        __builtin_amdgcn_s_sleep(1);
        if ((++sp & 255u) == 0u) { if (xb_ld(&bar[XB_TMO])) break; if (sp > XB_SPIN_CAP) { atomicAdd(&bar[XB_TMO], 1u); break; } }
    }
    nloc = mine > 0u ? mine : 1u; nx = cnt > 0u ? cnt : 1u;
}
__device__ __forceinline__ void xcd_barrier(unsigned* bar, volatile LAS unsigned* st) {
    asm volatile("s_waitcnt vmcnt(0)" ::: "memory");
    __syncthreads();
    if (threadIdx.x == 0) {
        __builtin_amdgcn_s_waitcnt(0);
        const unsigned x = xb_xcc_id();
        unsigned nloc = st[0], nx = st[1];
        if (nloc == 0u) { xcd_barrier_complete(bar, x, nloc, nx); st[0] = nloc; st[1] = nx; }
        const unsigned old = xb_add(&bar[XB_XSUB(x)], 1u);
        const unsigned gen = old / nloc;
        if (old + 1u == (gen + 1u) * nloc) {
            __builtin_amdgcn_fence(__ATOMIC_RELEASE, "agent");
            asm volatile("s_waitcnt vmcnt(0)" ::: "memory");
            const unsigned og = xb_add(&bar[XB_TOP], 1u);
            const unsigned tg = og / nx;
            if (og + 1u == (tg + 1u) * nx) xb_add(&bar[XB_TOPGEN], 1u);
            else XB_SPIN(xb_ld(&bar[XB_TOPGEN]) == tg, bar);
            __builtin_amdgcn_fence(__ATOMIC_ACQUIRE, "agent");
            xb_add(&bar[XB_XGEN(x)], 1u);
            asm volatile("s_waitcnt vmcnt(0)" ::: "memory");
        } else {
            XB_SPIN(xb_ld(&bar[XB_XGEN(x)]) == gen, bar);
            __builtin_amdgcn_fence(__ATOMIC_ACQUIRE, "agent");
            asm volatile("s_waitcnt vmcnt(0)" ::: "memory");
        }
    }
    __syncthreads();
}

struct Args { const float* in[29]; float* out; unsigned char* ws; int ph_lo, ph_hi; };
struct Frame {
    LAS unsigned char* lds; int tid, lane, wave, G, bid;
    volatile LAS unsigned long long* inl; float* out; unsigned char* ws;
};
__device__ __forceinline__ const float* INP(const Frame& F, int k) { const unsigned long long v = F.inl[k]; const unsigned lo = __builtin_amdgcn_readfirstlane((unsigned)v), hi = __builtin_amdgcn_readfirstlane((unsigned)(v >> 32)); return (const float*)(((unsigned long long)hi << 32) | lo); }
#define IN_X 0
#define IN_C 1
#define IN_ADAW 2
#define IN_ADAB 3
#define IN_MIXG 4
#define IN_FFNG 5
#define IN_WIN 6
#define IN_GATEB 7
#define IN_CPOS 8
#define IN_CW1 9
#define IN_CB1 10
#define IN_CW2 11
#define IN_CB2 12
#define IN_LCW 13
#define IN_LCB 14
#define IN_LWA 15
#define IN_LBA 16
#define IN_LWX 17
#define IN_LBX 18
#define IN_LLAM 19
#define IN_NSAG 20
#define IN_LRUG 21
#define IN_WOUT 22
#define IN_WG 23
#define IN_WU 24
#define IN_FCW 25
#define IN_FCB 26
#define IN_WD 27
#define IN_FING 28

__device__ __forceinline__ void ph_mod(const Frame& F) {
    LAS float* cact = (LAS float*)F.lds;
    LAS float* part = cact + 8192;
    const float* c = INP(F, IN_C);
    for (int i = F.tid; i < NB * D; i += 512) { const float v = c[i]; cact[i] = siluf_(v); }
    __syncthreads();
    float* mod = (float*)(F.ws + WS_MOD);
    for (int item = F.bid; item < NL * 192; item += F.G) {
        const int l = item / 192, n0 = (item % 192) * 32, col = F.lane & 31, kp = F.lane >> 5;
        const float* w = INP(F, IN_ADAW) + (size_t)l * D * 6144 + n0 + col;
        float acc[8];
#pragma unroll
        for (int b = 0; b < 8; ++b) acc[b] = 0.f;
#pragma unroll 32
        for (int i = 0; i < 64; ++i) { const int k = F.wave * 128 + 2 * i + kp; const float wv = __builtin_nontemporal_load(w + (size_t)k * 6144);
#pragma unroll
            for (int b = 0; b < 8; ++b) acc[b] += cact[b * D + k] * wv; }
#pragma unroll
        for (int b = 0; b < 8; ++b) acc[b] += __shfl_xor(acc[b], 32);
        if (F.lane < 32) {
#pragma unroll
            for (int b = 0; b < 8; ++b) part[(F.wave * 8 + b) * 32 + col] = acc[b]; }
        __syncthreads();
        if (F.tid < 256) { const int b = F.tid >> 5, cc = F.tid & 31; float s = 0.f;
#pragma unroll
            for (int w8 = 0; w8 < 8; ++w8) s += part[(w8 * 8 + b) * 32 + cc];
            mod[(size_t)(l * NB + b) * 6144 + n0 + cc] = s + INP(F, IN_ADAB)[l * 6144 + n0 + cc]; }
        __syncthreads();
    }
}
template <class SRC> __device__ __forceinline__ void tr_tile(const SRC& src, int K, bf16_t* dst, int k0, int n0, LAS float* scr, int lane) {
    float tv[32];
#pragma unroll
    for (int i = 0; i < 32; ++i) tv[i] = src(k0 + 2 * i + (lane >> 5), n0 + (lane & 31));
#pragma unroll
    for (int i = 0; i < 32; ++i) scr[(2 * i + (lane >> 5)) * 33 + (lane & 31)] = tv[i];
    LDS_WAIT(); asm volatile("" ::: "memory");
    const int c = lane & 7;
#pragma unroll
    for (int j = 0; j < 4; ++j) { const int n = (lane >> 3) + 8 * j; const LAS float* s = scr + (8 * c) * 33 + n;
        u32x4 o; o.x = cvt_pk_bf16(s[0 * 33], s[1 * 33]); o.y = cvt_pk_bf16(s[2 * 33], s[3 * 33]); o.z = cvt_pk_bf16(s[4 * 33], s[5 * 33]); o.w = cvt_pk_bf16(s[6 * 33], s[7 * 33]);
        *(u32x4*)(dst + (size_t)(n0 + n) * K + k0 + 8 * c) = o; }
    LDS_WAIT(); asm volatile("" ::: "memory");
}
__device__ __forceinline__ void ph_posp(const Frame& F) {
    LAS float* red = (LAS float*)F.lds;
    for (int vb = F.bid; vb < NL * 2 * 32; vb += F.G) { const int lk = vb >> 5, sl = vb & 31, n = F.tid & 255, kh = F.tid >> 8;
        const float* W = INP(F, IN_CW1) + (size_t)lk * 2048 * 256 + (size_t)(sl * 64 + kh * 32) * 256 + n; const float* pos = INP(F, IN_CPOS) + (size_t)lk * 2048 + sl * 64 + kh * 32;
        float sacc = 0.f;
#pragma unroll
        for (int k = 0; k < 32; ++k) sacc += pos[k] * W[(size_t)k * 256];
        __syncthreads();
        if (kh) red[n] = sacc;
        __syncthreads();
        if (!kh) ((float*)(F.ws + WS_POSP))[((size_t)lk * 32 + sl) * 256 + n] = sacc + red[n]; }
}
__device__ __forceinline__ void ph_convert(const Frame& F) {
    LAS float* scr = (LAS float*)(F.lds + 40960 + F.wave * 8704);
    const int gw = F.bid * 8 + F.wave, NGW = F.G * 8;
    constexpr int I_WIN = 16 * 80, I_WOUT = 16 * 32, I_WGU = 16 * 176, I_WDN = 44 * 32, I_CW1 = 2 * 32 * 8, I_CW2 = 2 * 4 * 2, I_LRU = 8 * 4, I_L = I_WIN + I_WOUT + I_WGU + I_WDN + I_CW1 + I_CW2 + I_LRU;
    for (int it = gw; it < NL * I_L; it += NGW) {
        const int l = it / I_L; int r = it % I_L;
        unsigned char* wl = F.ws + WS_WTS + (size_t)l * WTS_LAYER;
        if (r < I_WIN) { const float* W = INP(F, IN_WIN) + (size_t)l * D * NINSRC;
            auto src = [=](int k, int n) -> float { return n < 1280 ? __builtin_nontemporal_load(W + (size_t)k * NINSRC + n) : n < 2304 ? __builtin_nontemporal_load(W + (size_t)k * NINSRC + n + 24) : n < 2328 ? __builtin_nontemporal_load(W + (size_t)k * NINSRC + n - 1024) : 0.f; };
            tr_tile(src, D, (bf16_t*)(wl + WO_WIN), (r / 80) * 64, (r % 80) * 32, scr, F.lane); continue; } r -= I_WIN;
        if (r < I_WOUT) { const float* W = INP(F, IN_WOUT) + (size_t)l * D * D; const float* g1 = INP(F, IN_NSAG) + l * 512; const float* g2 = INP(F, IN_LRUG) + l * 512;
            auto src = [=](int k, int n) -> float { return __builtin_nontemporal_load(W + (size_t)k * D + n) * (k < 512 ? g1[k] : g2[k - 512]); };
            tr_tile(src, D, (bf16_t*)(wl + WO_WOUT), (r / 32) * 64, (r % 32) * 32, scr, F.lane); continue; } r -= I_WOUT;
        if (r < I_WGU) { const float* Wg = INP(F, IN_WG) + (size_t)l * D * FF; const float* Wu = INP(F, IN_WU) + (size_t)l * D * FF;
            auto src = [=](int k, int n) -> float { const int un = n >> 8, w = n & 255; return w < 128 ? __builtin_nontemporal_load(Wg + (size_t)k * FF + un * 128 + w) : __builtin_nontemporal_load(Wu + (size_t)k * FF + un * 128 + w - 128); };
            tr_tile(src, D, (bf16_t*)(wl + WO_WGU), (r / 176) * 64, (r % 176) * 32, scr, F.lane); continue; } r -= I_WGU;
        if (r < I_WDN) { const float* W = INP(F, IN_WD) + (size_t)l * FF * D;
            auto src = [=](int k, int n) -> float { return __builtin_nontemporal_load(W + (size_t)k * D + n); };
            tr_tile(src, FF, (bf16_t*)(wl + WO_WDN), (r / 32) * 64, (r % 32) * 32, scr, F.lane); continue; } r -= I_WDN;
        if (r < I_CW1) { const int kv = r / 256, rr = r % 256, nt = rr >> 5, ksb = (rr & 31) * 4; const float* W = INP(F, IN_CW1) + (size_t)(l * 2 + kv) * 2048 * 256;
            bf16_t* dst = (bf16_t*)(wl + WO_CW1) + (((size_t)(kv * 8 + nt) * 128 + ksb) * 64 + F.lane) * 8;
#pragma unroll
            for (int q = 0; q < 4; ++q) { const int k0 = 16 * (ksb + q) + 8 * (F.lane >> 5), nn = 32 * nt + (F.lane & 31); float v[8];
#pragma unroll
                for (int j = 0; j < 8; ++j) v[j] = W[(size_t)(k0 + j) * 256 + nn];
                u32x4 o; o.x = pk2(v[0], v[1]); o.y = pk2(v[2], v[3]); o.z = pk2(v[4], v[5]); o.w = pk2(v[6], v[7]); *(u32x4*)(dst + (size_t)q * 512) = o; }
            continue; } r -= I_CW1;
        if (r < I_CW2) { const int kv = r / 8, rr = r % 8; const float* W = INP(F, IN_CW2) + (size_t)(l * 2 + kv) * 256 * 64;
            auto src = [=](int k, int n) -> float { return W[(size_t)k * 64 + n]; };
            tr_tile(src, 256, (bf16_t*)(wl + WO_CW2) + (size_t)kv * 64 * 256, (rr / 2) * 64, (rr % 2) * 32, scr, F.lane); continue; } r -= I_CW2;
        { const int blk = r / 4, nb = r % 4; const float* Wa = INP(F, IN_LWA) + (size_t)(l * 8 + blk) * 4096; const float* Wx = INP(F, IN_LWX) + (size_t)(l * 8 + blk) * 4096;
            auto src = [=](int k, int n) -> float { return n < 64 ? Wa[k * 64 + n] : Wx[k * 64 + n - 64]; };
            tr_tile(src, 64, (bf16_t*)(wl + WO_LRUW) + (size_t)blk * 128 * 64, 0, nb * 32, scr, F.lane); }
    }
}

__device__ __forceinline__ void ph_prep(const Frame& F) {
    const float* mod = (const float*)(F.ws + WS_MOD);
    for (int vb = F.bid; vb < 256; vb += F.G) {
        const int l = vb >> 6, sub = vb & 63; const bool isg = sub >= 20; const int rbase = (isg ? sub - 20 : sub) * 128;
        constexpr int SHS = 2112;
        LAS unsigned char* shl = F.lds;
        __syncthreads();
        for (int i = F.tid; i < NB * D / 2; i += 512) { const int b = i >> 9, k = (i & 511) * 2;
            const f32x2 v = *(const f32x2*)(mod + (size_t)(l * NB + b) * 6144 + (isg ? 3072 : 0) + k);
            const unsigned h0 = f2bf(v.x), h1 = f2bf(v.y);
            *(LAS unsigned*)(shl + b * SHS + k * 2) = h0 | (h1 << 16);
            *(LAS unsigned*)(shl + (8 + b) * SHS + k * 2) = pk2(v.x - bf2f(h0), v.y - bf2f(h1)); }
        __syncthreads();
        const bf16_t* Wt = (const bf16_t*)(F.ws + WS_WTS + (size_t)l * WTS_LAYER + (isg ? WO_WGU : WO_WIN));
        float* dst = (float*)(F.ws + (isg ? WS_SHWG : WS_SHW1)) + (size_t)l * NB * (isg ? NGU : NIN); const int ldn = isg ? NGU : NIN;
        const int n0 = rbase + F.wave * 16, fr = F.lane & 15, fq = F.lane >> 4;
        const bf16_t* wp = Wt + (size_t)(n0 + fr) * D + 8 * fq;
        const LAS unsigned char* bp = shl + (fr & 7) * SHS + 16 * fq;
        f32x4 acc = {0.f, 0.f, 0.f, 0.f};
#pragma unroll
        for (int h = 0; h < 2; ++h) {
            bf16x8 af[16];
#pragma unroll
            for (int q = 0; q < 16; ++q) af[q] = *(const bf16x8*)(wp + (h * 16 + q) * 32);
#pragma unroll
            for (int q = 0; q < 16; ++q) { const int ko = (h * 16 + q) * 64;
                const bf16x8 bh = *(const LAS bf16x8*)(bp + ko), bl = *(const LAS bf16x8*)(bp + 8 * SHS + ko);
                acc = __builtin_amdgcn_mfma_f32_16x16x32_bf16(af[q], bh, acc, 0, 0, 0); acc = __builtin_amdgcn_mfma_f32_16x16x32_bf16(af[q], bl, acc, 0, 0, 0); }
        }
        if (fr < 8) *(f32x4*)(dst + (size_t)fr * ldn + n0 + 4 * fq) = acc;
    }
    __syncthreads();
    {   float* posb = (float*)(F.ws + WS_POSB); const float* posp = (const float*)(F.ws + WS_POSP);
        for (int i = F.bid * 512 + F.tid; i < NL * 2 * 256; i += F.G * 512) { const int n = i & 255, lk = i >> 8; float sacc = INP(F, IN_CB1)[lk * 256 + n];
#pragma unroll
            for (int sl = 0; sl < 32; ++sl) sacc += posp[((size_t)lk * 32 + sl) * 256 + n];
            posb[i] = sacc; }
    }
    {   float* fcw = (float*)(F.ws + WS_FCW);
        for (int i = F.bid * 512 + F.tid; i < NL * 4 * FF; i += F.G * 512) { const int col = i % FF, k = (i / FF) & 3, l = i / (4 * FF); fcw[i] = k < 3 ? INP(F, IN_FCW)[(size_t)(l * 3 + k) * FF + col] : INP(F, IN_FCB)[(size_t)l * FF + col]; }
    }
    {
        float* gs = (float*)(F.ws + WS_GS);
        for (int i = F.bid * 512 + F.tid; i < NL * 2 * NB * D; i += F.G * 512) { const int col = i & 1023, b = (i >> 10) & 7, w = (i >> 13) & 1, l = i >> 14;
            gs[i] = INP(F, w ? IN_FFNG : IN_MIXG)[l * D + col] * (1.0f + mod[(size_t)(l * NB + b) * 6144 + (w ? 4096 : 1024) + col]); }
    }
    {
        const float* x = INP(F, IN_X); bf16_t* XG = (bf16_t*)(F.ws + WS_XG); float* rowss = (float*)(F.ws + WS_ROWSS); const float* mg = INP(F, IN_MIXG);
        for (int rw = (F.bid * 8 + F.wave) * 8; rw < T; rw += F.G * 64) { const int b = rw >> 11; f32x4 gm[4], v[4];
#pragma unroll
            for (int j = 0; j < 4; ++j) { const int col = j * 256 + F.lane * 4; v[j] = __builtin_nontemporal_load((const f32x4*)(x + (size_t)rw * D + col));
                gm[j] = *(const f32x4*)(mg + col) * (*(const f32x4*)(mod + (size_t)b * 6144 + 1024 + col) + 1.0f); }
#pragma unroll 1
            for (int i = 0; i < 8; ++i) { const int row = rw + i, rn = i < 7 ? row + 1 : row; f32x4 nv[4]; float ss = 0.f;
#pragma unroll
                for (int j = 0; j < 4; ++j) nv[j] = __builtin_nontemporal_load((const f32x4*)(x + (size_t)rn * D + j * 256 + F.lane * 4));
#pragma unroll
                for (int j = 0; j < 4; ++j) { const int col = j * 256 + F.lane * 4; ss += (v[j][0] * v[j][0] + v[j][1] * v[j][1]) + (v[j][2] * v[j][2] + v[j][3] * v[j][3]);
                    const f32x4 y = v[j] * gm[j]; u32x2 w; w.x = pk2(y[0], y[1]); w.y = pk2(y[2], y[3]); *(u32x2*)(XG + (size_t)row * D + col) = w; }
                ss = wave_sum(ss);
                if (F.lane < 16) rowss[(size_t)row * 16 + F.lane] = F.lane == 0 ? ss : 0.f;
#pragma unroll
                for (int j = 0; j < 4; ++j) v[j] = nv[j]; } }
    }
}

namespace at {
typedef float f32x16 __attribute__((ext_vector_type(16)));
typedef short v4i16_t __attribute__((ext_vector_type(4)));
constexpr int BUF = 16384;
__device__ __forceinline__ int crow(int r, int hi) { return (r & 3) + 8 * (r >> 2) + 4 * hi; }
struct Stg { u32x4 k, v; };
__device__ __forceinline__ void stage_load(Stg& s, const bf16_t* Kg, const bf16_t* Vg, int key0, int wid, int lane) {
    s.k = *(const u32x4*)(Kg + (size_t)(key0 + lane) * 64 + wid * 8);
    s.v = *(const u32x4*)(Vg + (size_t)(key0 + 16 * (wid & 3) + (lane >> 2)) * 64 + (wid >> 2) * 32 + (lane & 3) * 8);
}
__device__ __forceinline__ void stage_write(const Stg& s, LAS unsigned char* buf, int wid, int lane) {
    *(LAS u32x4*)(buf + wid * 1024 + lane * 16) = s.k;
    *(LAS u32x4*)(buf + 8192 + wid * 1024 + lane * 16) = s.v;
}
__device__ __forceinline__ void qkt(f32x16& p0, f32x16& p1, const LAS unsigned char* buf, const bf16x8 (&qr)[4], int r32, int hi) {
    const LAS unsigned char* kb = buf + hi * 1024 + r32 * 16;
    bf16x8 b0[4], b1[4];
#pragma unroll
    for (int d0 = 0; d0 < 4; ++d0) { b0[d0] = *(const LAS bf16x8*)(kb + d0 * 2048); b1[d0] = *(const LAS bf16x8*)(kb + d0 * 2048 + 512); }
    asm volatile("s_waitcnt lgkmcnt(0)" ::: "memory");
#pragma unroll
    for (int d0 = 0; d0 < 4; ++d0) { p0 = __builtin_amdgcn_mfma_f32_32x32x16_bf16(b0[d0], qr[d0], p0, 0, 0, 0); p1 = __builtin_amdgcn_mfma_f32_32x32x16_bf16(b1[d0], qr[d0], p1, 0, 0, 0); }
}
__device__ __forceinline__ bf16x8 vfrag(const LAS unsigned char* p) {
    const v4i16_t lo = __builtin_amdgcn_ds_read_tr16_b64_v4i16((LAS v4i16_t*)p), hi = __builtin_amdgcn_ds_read_tr16_b64_v4i16((LAS v4i16_t*)(p + 512));
    return (bf16x8){lo[0], lo[1], lo[2], lo[3], hi[0], hi[1], hi[2], hi[3]};
}
__device__ __forceinline__ bf16x8 pack8(const f32x16& p, int base) {
    u32x4 w; w.x = cvt_pk_bf16(p[base], p[base + 1]); w.y = cvt_pk_bf16(p[base + 2], p[base + 3]); w.z = cvt_pk_bf16(p[base + 4], p[base + 5]); w.w = cvt_pk_bf16(p[base + 6], p[base + 7]);
    return __builtin_bit_cast(bf16x8, w);
}
__device__ __forceinline__ void pv(f32x16 (&o)[2], const LAS unsigned char* buf, const f32x16& p0, const f32x16& p1, int lane, int hi) {
    const LAS unsigned char* vb = buf + 8192 + ((lane >> 4) & 1) * 32 + (lane & 3) * 8 + (4 * hi + ((lane & 15) >> 2)) * 64;
    const bf16x8 P0 = pack8(p0, 0), P1 = pack8(p0, 8), P2 = pack8(p1, 0), P3 = pack8(p1, 8);
#pragma unroll
    for (int d0 = 0; d0 < 2; ++d0) {
        o[d0] = __builtin_amdgcn_mfma_f32_32x32x16_bf16(vfrag(vb + d0 * 4096), P0, o[d0], 0, 0, 0);
        o[d0] = __builtin_amdgcn_mfma_f32_32x32x16_bf16(vfrag(vb + d0 * 4096 + 1024), P1, o[d0], 0, 0, 0);
        o[d0] = __builtin_amdgcn_mfma_f32_32x32x16_bf16(vfrag(vb + d0 * 4096 + 2048), P2, o[d0], 0, 0, 0);
        o[d0] = __builtin_amdgcn_mfma_f32_32x32x16_bf16(vfrag(vb + d0 * 4096 + 3072), P3, o[d0], 0, 0, 0); }
}
__device__ __forceinline__ float xhalf(float v) { return __shfl_xor(v, 32); }
__device__ __forceinline__ float max3f(float a, float b, float c) { float r; asm("v_max3_f32 %0, %1, %2, %3" : "=v"(r) : "v"(a), "v"(b), "v"(c)); return r; }
__device__ __forceinline__ float rowmax32(f32x16& p0, f32x16& p1) {
    asm volatile("s_nop 15\n\ts_nop 7" : "+v"(p0), "+v"(p1));
    float a = max3f(p0[0], p0[1], p1[0]), b = max3f(p0[2], p0[3], p1[1]); a = max3f(a, p1[2], p1[3]);
#pragma unroll
    for (int r = 4; r < 16; r += 4) { a = max3f(a, p0[r], p0[r + 1]); b = max3f(b, p0[r + 2], p0[r + 3]); a = max3f(a, p1[r], p1[r + 1]); b = max3f(b, p1[r + 2], p1[r + 3]); }
    a = max3f(a, b, b);
    return max3f(a, xhalf(a), a);
}
constexpr float MASKED = -1.0e6f;
__device__ __forceinline__ void softmax_step(f32x16& p0, f32x16& p1, float& m, float& l, f32x16 (&o)[2], f32x16& negm) {
    const float rm = rowmax32(p0, p1);
    if (__any(rm > 0.f)) { const float dl = fmaxf(rm, 0.f), f = __builtin_amdgcn_exp2f(-dl); m += dl; l *= f;
#pragma unroll
        for (int r = 0; r < 16; ++r) { p0[r] -= dl; p1[r] -= dl; o[0][r] *= f; o[1][r] *= f; negm[r] = -m; } }
    float s = 0.f;
#pragma unroll
    for (int r = 0; r < 16; ++r) { p0[r] = __builtin_amdgcn_exp2f(p0[r]); p1[r] = __builtin_amdgcn_exp2f(p1[r]); s += p0[r] + p1[r]; }
    l += s;
}
__device__ __forceinline__ void partial_sm(f32x16& p0, f32x16& p1, float& m, float& l, f32x16 (&o)[2]) {
    float mx[8];
#pragma unroll
    for (int r = 0; r < 8; ++r) mx[r] = __builtin_fmaxf(__builtin_fmaxf(p0[2 * r], p0[2 * r + 1]), __builtin_fmaxf(p1[2 * r], p1[2 * r + 1]));
    float rm = __builtin_fmaxf(__builtin_fmaxf(__builtin_fmaxf(mx[0], mx[1]), __builtin_fmaxf(mx[2], mx[3])), __builtin_fmaxf(__builtin_fmaxf(mx[4], mx[5]), __builtin_fmaxf(mx[6], mx[7])));
    rm = __builtin_fmaxf(rm, xhalf(rm));
    if (__any(rm > 0.f)) { const float dl = fmaxf(rm, 0.f), f = __builtin_amdgcn_exp2f(-dl); m += dl; l *= f;
#pragma unroll
        for (int r = 0; r < 16; ++r) { p0[r] -= dl; p1[r] -= dl; o[0][r] *= f; o[1][r] *= f; } }
}
__device__ __forceinline__ void finish_sm(f32x16& p0, f32x16& p1, float& l, bf16x8 (&pa)[4]) {
    float s = 0.f;
#pragma unroll
    for (int r = 0; r < 16; ++r) { p0[r] = __builtin_amdgcn_exp2f(p0[r]); p1[r] = __builtin_amdgcn_exp2f(p1[r]); s += p0[r] + p1[r]; }
    l += s;
    pa[0] = pack8(p0, 0); pa[1] = pack8(p0, 8); pa[2] = pack8(p1, 0); pa[3] = pack8(p1, 8);
}
__device__ __forceinline__ void pv_pk(f32x16 (&o)[2], const LAS unsigned char* buf, const bf16x8 (&pa)[4], int lane, int hi) {
    const LAS unsigned char* vb = buf + 8192 + ((lane >> 4) & 1) * 32 + (lane & 3) * 8 + (4 * hi + ((lane & 15) >> 2)) * 64;
    bf16x8 vf[2][4];
#pragma unroll
    for (int d0 = 0; d0 < 2; ++d0)
#pragma unroll
        for (int k4 = 0; k4 < 4; ++k4) vf[d0][k4] = vfrag(vb + d0 * 4096 + k4 * 1024);
    asm volatile("s_waitcnt lgkmcnt(0)" ::: "memory");
#pragma unroll
    for (int d0 = 0; d0 < 2; ++d0) {
        o[d0] = __builtin_amdgcn_mfma_f32_32x32x16_bf16(vf[d0][0], pa[0], o[d0], 0, 0, 0);
        o[d0] = __builtin_amdgcn_mfma_f32_32x32x16_bf16(vf[d0][1], pa[1], o[d0], 0, 0, 0);
        o[d0] = __builtin_amdgcn_mfma_f32_32x32x16_bf16(vf[d0][2], pa[2], o[d0], 0, 0, 0);
        o[d0] = __builtin_amdgcn_mfma_f32_32x32x16_bf16(vf[d0][3], pa[3], o[d0], 0, 0, 0); }
}
template <bool SEL> __device__ __forceinline__ void score_tile(f32x16& p0, f32x16& p1, const LAS unsigned char* stg, int tile, int qb, unsigned mask, const bf16x8 (&qr)[4], int tq, int r32, int hi, float m) {
    float c0 = -m; if constexpr (SEL) { const bool selb = (mask >> tile) & 1u; c0 = selb ? c0 : MASKED; }
#pragma unroll
    for (int r = 0; r < 16; ++r) { p0[r] = c0; p1[r] = c0; }
    qkt(p0, p1, stg, qr, r32, hi);
}
template <bool SEL> __device__ __forceinline__ void bound_mask(f32x16& p0, f32x16& p1, int tile, int qb, int tq, int hi) {
    if (tile == qb || (!SEL && tile + 8 == qb)) {
        const bool cz = tile == qb; const int lim = tq - 4 * hi;
#pragma unroll
        for (int r = 0; r < 16; ++r) { const int c0 = (r & 3) + 8 * (r >> 2), c1 = c0 + 32;
            const bool v0 = cz ? (c0 <= lim) : (c0 > lim), v1 = cz ? (c1 <= lim) : (c1 > lim);
            p0[r] = v0 ? p0[r] : MASKED; p1[r] = v1 ? p1[r] : MASKED; } }
}
template <bool SEL> __device__ __forceinline__ void tile_pipe(f32x16 (&o)[2], float& lsum, const bf16_t* Kg, const bf16_t* Vg, int t_lo, int nt, int qb, unsigned mask, const bf16x8 (&qr)[4],
                                                             LAS unsigned char* lds, int tq, int wid, int lane, int r32, int hi) {
    float m = 0.f; lsum = 0.f;
#pragma unroll
    for (int r = 0; r < 16; ++r) { o[0][r] = 0.f; o[1][r] = 0.f; }
    LAS unsigned char* sC = lds; LAS unsigned char* sN = lds + BUF; LAS unsigned char* sW = lds + 2 * BUF;
    f32x16 pA0, pA1, pB0, pB1; Stg stA, stB;
    if (2 < nt) stage_load(stB, Kg, Vg, (t_lo + 2) * 64, wid, lane);
    score_tile<SEL>(pA0, pA1, sC, t_lo, qb, mask, qr, tq, r32, hi, m); bound_mask<SEL>(pA0, pA1, t_lo, qb, tq, hi); partial_sm(pA0, pA1, m, lsum, o);
#define AT_STEP(PC0, PC1, PN0, PN1, SL, SW_, I) do { const int i_ = (I); const bool hn_ = i_ + 1 < nt, hnn_ = i_ + 2 < nt; \
        if (i_ + 3 < nt) stage_load(SL, Kg, Vg, (t_lo + i_ + 3) * 64, wid, lane); \
        if (hnn_) stage_write(SW_, sW, wid, lane); \
        __builtin_amdgcn_sched_barrier(0); \
        if (hn_) score_tile<SEL>(PN0, PN1, sN, t_lo + i_ + 1, qb, mask, qr, tq, r32, hi, m); \
        bf16x8 pa_[4]; finish_sm(PC0, PC1, lsum, pa_); \
        __builtin_amdgcn_sched_barrier(0); \
        pv_pk(o, sC, pa_, lane, hi); \
        if (hn_) { bound_mask<SEL>(PN0, PN1, t_lo + i_ + 1, qb, tq, hi); partial_sm(PN0, PN1, m, lsum, o); } \
        asm volatile("s_waitcnt lgkmcnt(0)" ::: "memory"); __builtin_amdgcn_s_barrier(); asm volatile("" ::: "memory"); \
        { LAS unsigned char* t_ = sC; sC = sN; sN = sW; sW = t_; } } while (0)
#define AT_FULL(PC0, PC1, PN0, PN1, SL, SW_, I) do { const int i_ = (I); \
        stage_load(SL, Kg, Vg, (t_lo + i_ + 3) * 64, wid, lane); \
        stage_write(SW_, sW, wid, lane); \
        __builtin_amdgcn_sched_barrier(0); \
        score_tile<SEL>(PN0, PN1, sN, t_lo + i_ + 1, qb, mask, qr, tq, r32, hi, m); \
        bf16x8 pa_[4]; finish_sm(PC0, PC1, lsum, pa_); \
        __builtin_amdgcn_sched_barrier(0); \
        pv_pk(o, sC, pa_, lane, hi); \
        partial_sm(PN0, PN1, m, lsum, o); \
        asm volatile("s_waitcnt lgkmcnt(0)" ::: "memory"); __builtin_amdgcn_s_barrier(); asm volatile("" ::: "memory"); \
        { LAS unsigned char* t_ = sC; sC = sN; sN = sW; sW = t_; } } while (0)
    int i = 0;
    for (; i + 4 < nt; i += 2) { AT_FULL(pA0, pA1, pB0, pB1, stA, stB, i); AT_FULL(pB0, pB1, pA0, pA1, stB, stA, i + 1); }
    for (; i < nt; i += 2) { AT_STEP(pA0, pA1, pB0, pB1, stA, stB, i); if (i + 1 < nt) AT_STEP(pB0, pB1, pA0, pA1, stB, stA, i + 1); }
    __syncthreads();
#undef AT_FULL
#undef AT_STEP
}
constexpr float NEGBIG = -3.0e38f;
__device__ __forceinline__ void unit(const Frame& F, int l, int bg, int qb, unsigned* cmpdone) {
    int lane_ = F.lane; asm volatile("" : "+v"(lane_));
    const int wid = F.wave, lane = lane_, r32 = lane & 31, hi = lane >> 5, b = bg >> 1, g = bg & 1, rh = wid >> 1, hd = g * 4 + rh, tq = (wid & 1) * 32 + r32, t = qb * 64 + tq;
    LAS unsigned char* lds = F.lds;
    const size_t kvo = (size_t)bg * SEQ * 64;
    bf16x8 qr[4];
    {   const bf16_t* Q = (const bf16_t*)(F.ws + WS_Q) + ((size_t)b * SEQ + t) * 512 + hd * 64;
#pragma unroll
        for (int d0 = 0; d0 < 4; ++d0) qr[d0] = __builtin_nontemporal_load((const bf16x8*)(Q + d0 * 16 + hi * 8)); }
    float gt0, gt1, gt2;
    {   const float* ZG = (const float*)(F.ws + WS_ZG) + ((size_t)b * SEQ + t) * 24 + g * 12 + rh * 3; const float* gb = INP(F, IN_GATEB) + l * 24 + g * 12 + rh * 3;
        gt0 = sigmoidf_(ZG[0] + gb[0]); gt1 = sigmoidf_(ZG[1] + gb[1]); gt2 = sigmoidf_(ZG[2] + gb[2]); }
    f32x16 oacc[2];
    volatile LAS unsigned* rdy = (volatile LAS unsigned*)(F.lds + MISC_OFF + 252);
    __syncthreads();
    if (F.tid == 0) { const unsigned ok = __hip_atomic_load(cmpdone + bg, __ATOMIC_RELAXED, __HIP_MEMORY_SCOPE_AGENT) >= 4u ? 1u : 0u;
        if (ok) { __builtin_amdgcn_fence(__ATOMIC_ACQUIRE, "agent"); asm volatile("s_waitcnt vmcnt(0)" ::: "memory"); }
        *rdy = ok; }
    __syncthreads();
    const bool early = *rdy != 0u;
    const bf16_t* Kc = (const bf16_t*)(F.ws + WS_KCMP) + (size_t)bg * 8192; const bf16_t* Vc = (const bf16_t*)(F.ws + WS_KCMP) + (size_t)(16 + bg) * 8192;
    LAS unsigned char* cst = lds + 3 * BUF + 32768;
    {
        f32x16 o[2]; float lsum;
        const bf16_t* Kg = (const bf16_t*)(F.ws + WS_KV + 4 * KV_STRIDE) + kvo; const bf16_t* Vg = (const bf16_t*)(F.ws + WS_KV + 5 * KV_STRIDE) + kvo;
        const int t_lo = qb >= 8 ? qb - 8 : 0, nt = qb - t_lo + 1;
        {   Stg s0, s1, c0, c1; stage_load(s0, Kg, Vg, t_lo * 64, wid, lane); if (nt > 1) stage_load(s1, Kg, Vg, (t_lo + 1) * 64, wid, lane);
            if (early) { stage_load(c0, Kc, Vc, 0, wid, lane); stage_load(c1, Kc, Vc, 64, wid, lane); }
            stage_write(s0, lds, wid, lane); if (nt > 1) stage_write(s1, lds + BUF, wid, lane);
            if (early) { stage_write(c0, cst, wid, lane); stage_write(c1, cst + BUF, wid, lane); } }
        __syncthreads();
        tile_pipe<false>(o, lsum, Kg, Vg, t_lo, nt, qb, 0u, qr, lds, tq, wid, lane, r32, hi);
        lsum += xhalf(lsum);
        const float gate = gt2 / lsum;
#pragma unroll
        for (int r = 0; r < 16; ++r) { oacc[0][r] = o[0][r] * gate; oacc[1][r] = o[1][r] * gate; }
    }
    if (!early) {
        if (F.tid == 0) { unsigned sp = 0;
            while (__hip_atomic_load(cmpdone + bg, __ATOMIC_RELAXED, __HIP_MEMORY_SCOPE_AGENT) < 4u) { __builtin_amdgcn_s_sleep(2); if (++sp > (1u << 22)) break; }
            __builtin_amdgcn_fence(__ATOMIC_ACQUIRE, "agent"); asm volatile("s_waitcnt vmcnt(0)" ::: "memory"); }
        __syncthreads();
        Stg sc0, sc1; stage_load(sc0, Kc, Vc, 0, wid, lane); stage_load(sc1, Kc, Vc, 64, wid, lane); stage_write(sc0, cst, wid, lane); stage_write(sc1, cst + BUF, wid, lane);
        __syncthreads();
    }
    LAS float* impp = (LAS float*)(lds + 3 * BUF);
    LAS unsigned* selm = (LAS unsigned*)(lds + 3 * BUF + 65536);
    LAS float* ssq = (LAS float*)(lds + 3 * BUF + 65536 + 256);
    LAS unsigned char* park = lds + 3 * BUF + (size_t)F.tid * 16;
    {
        f32x16 p[4];
#pragma unroll
        for (int x = 0; x < 4; ++x)
#pragma unroll
            for (int r = 0; r < 16; ++r) p[x][r] = 0.f;
        qkt(p[0], p[1], cst, qr, r32, hi); qkt(p[2], p[3], cst + BUF, qr, r32, hi);
        float mx = -1e30f; const int clim = ((t - 31) >> 4) - 4 * hi;
#pragma unroll
        for (int x = 0; x < 4; ++x)
#pragma unroll
            for (int r = 0; r < 16; ++r) { const int c0 = 32 * x + (r & 3) + 8 * (r >> 2); const bool v = (c0 <= clim) && !(x == 3 && r == 15 && hi == 1); p[x][r] = v ? p[x][r] : NEGBIG; mx = fmaxf(mx, p[x][r]); }
        mx = fmaxf(mx, xhalf(mx)); float sm = 0.f;
#pragma unroll
        for (int x = 0; x < 4; ++x)
#pragma unroll
            for (int r = 0; r < 16; ++r) { p[x][r] = __builtin_amdgcn_exp2f(p[x][r] - mx); sm += p[x][r]; }
        sm += xhalf(sm); const float inv = sm > 0.f ? 1.0f / sm : 0.f;
#pragma unroll
        for (int x = 0; x < 4; ++x)
#pragma unroll
            for (int r = 0; r < 16; ++r) p[x][r] *= inv;
        float eprev = 0.f;
#pragma unroll
        for (int i = 0; i < 16; ++i) { const int x = i >> 2, k = i & 3; const float gsum = (p[x][4 * k] + p[x][4 * k + 1]) + (p[x][4 * k + 2] + p[x][4 * k + 3]), eo = xhalf(p[x][4 * k + 3]);
            impp[(rh * 64 + tq) * 32 + 2 * i + hi] = gsum + (hi ? eo : eprev); eprev = eo; }
        f32x16 oc[2]; oc[0] = (f32x16){}; oc[1] = (f32x16){};
        pv(oc, cst, p[0], p[1], lane, hi); pv(oc, cst + BUF, p[2], p[3], lane, hi);
#pragma unroll
        for (int r = 0; r < 16; ++r) { oacc[0][r] += oc[0][r] * gt0; oacc[1][r] += oc[1][r] * gt0; }
    }
    __syncthreads();
    const bf16_t* Kg = (const bf16_t*)(F.ws + WS_KV + 2 * KV_STRIDE) + kvo; const bf16_t* Vg = (const bf16_t*)(F.ws + WS_KV + 3 * KV_STRIDE) + kvo;
    {   Stg s0, s1; stage_load(s0, Kg, Vg, 0, wid, lane); if (qb > 0) stage_load(s1, Kg, Vg, 64, wid, lane);
        stage_write(s0, lds, wid, lane); if (qb > 0) stage_write(s1, lds + BUF, wid, lane); }
    {
        const int qq = 8 * wid + (lane >> 3), sub = lane & 7;
        unsigned smask = qb >= 31 ? 0xffffffffu : ((2u << qb) - 1u);
        if (qb >= 8) {
            float v[4];
#pragma unroll
            for (int e = 0; e < 4; ++e) { const int j = 4 * sub + e; const float sv = (impp[qq * 32 + j] + impp[(64 + qq) * 32 + j]) + (impp[(128 + qq) * 32 + j] + impp[(192 + qq) * 32 + j]); v[e] = (j >= 1 && j <= qb - 2) ? sv : -1e30f; }
            smask = 1u | (3u << (qb - 1));
#pragma unroll 1
            for (int k = 0; k < 5; ++k) { float best = v[0]; int bi = 4 * sub;
#pragma unroll
                for (int e = 1; e < 4; ++e) { const bool gt = v[e] > best; best = gt ? v[e] : best; bi = gt ? 4 * sub + e : bi; }
#pragma unroll
                for (int sft = 0; sft < 3; ++sft) {
                    float ov; int oi;
                    if (sft == 0) { ov = __int_as_float(__builtin_amdgcn_update_dpp(0, __float_as_int(best), 0xB1, 0xf, 0xf, true)); oi = __builtin_amdgcn_update_dpp(0, bi, 0xB1, 0xf, 0xf, true); }
                    else if (sft == 1) { ov = __int_as_float(__builtin_amdgcn_update_dpp(0, __float_as_int(best), 0x4E, 0xf, 0xf, true)); oi = __builtin_amdgcn_update_dpp(0, bi, 0x4E, 0xf, 0xf, true); }
                    else { ov = __int_as_float(__builtin_amdgcn_update_dpp(0, __float_as_int(best), 0x141, 0xf, 0xf, true)); oi = __builtin_amdgcn_update_dpp(0, bi, 0x141, 0xf, 0xf, true); }
                    const bool take = (ov > best) || (ov == best && oi < bi); best = take ? ov : best; bi = take ? oi : bi; }
                smask |= 1u << bi;
#pragma unroll
                for (int e = 0; e < 4; ++e) v[e] = (4 * sub + e == bi) ? -3.4e38f : v[e]; }
        }
        if (sub == 0) selm[qq] = smask;
    }
    __syncthreads();
    const unsigned mask = selm[tq];
#pragma unroll
    for (int d0 = 0; d0 < 2; ++d0)
#pragma unroll
        for (int q4 = 0; q4 < 4; ++q4) *(LAS f32x4*)(park + (d0 * 4 + q4) * 8192) = (f32x4){oacc[d0][4 * q4], oacc[d0][4 * q4 + 1], oacc[d0][4 * q4 + 2], oacc[d0][4 * q4 + 3]};
    f32x16 o[2]; float lsum;
    tile_pipe<true>(o, lsum, Kg, Vg, 0, qb + 1, qb, mask, qr, lds, tq, wid, lane, r32, hi);
#pragma unroll
    for (int d0 = 0; d0 < 2; ++d0)
#pragma unroll
        for (int q4 = 0; q4 < 4; ++q4) { const f32x4 v = *(const LAS f32x4*)(park + (d0 * 4 + q4) * 8192); oacc[d0][4 * q4] = v[0]; oacc[d0][4 * q4 + 1] = v[1]; oacc[d0][4 * q4 + 2] = v[2]; oacc[d0][4 * q4 + 3] = v[3]; }
    lsum += xhalf(lsum);
    const float g1 = gt1 / lsum;
    bf16_t* MX = (bf16_t*)(F.ws + WS_MIXED) + ((size_t)b * SEQ + t) * D + hd * 64;
    float ss = 0.f;
#pragma unroll
    for (int d0 = 0; d0 < 2; ++d0)
#pragma unroll
        for (int i = 0; i < 4; ++i) {
            const float v0 = oacc[d0][4 * i] + g1 * o[d0][4 * i], v1 = oacc[d0][4 * i + 1] + g1 * o[d0][4 * i + 1], v2 = oacc[d0][4 * i + 2] + g1 * o[d0][4 * i + 2], v3 = oacc[d0][4 * i + 3] + g1 * o[d0][4 * i + 3];
            ss += (v0 * v0 + v1 * v1) + (v2 * v2 + v3 * v3);
            u32x2 w; w.x = cvt_pk_bf16(v0, v1); w.y = cvt_pk_bf16(v2, v3); *(u32x2*)(MX + d0 * 32 + 8 * i + 4 * hi) = w; }
    ss += xhalf(ss);
    if (hi == 0) ssq[tq * 4 + rh] = ss;
    __syncthreads();
    if (F.tid < 64) { float* SSN = (float*)(F.ws + WS_SSN); SSN[((size_t)b * SEQ + qb * 64 + F.tid) * 2 + g] = (ssq[F.tid * 4] + ssq[F.tid * 4 + 1]) + (ssq[F.tid * 4 + 2] + ssq[F.tid * 4 + 3]); }
}
}

namespace lr {
typedef float f32x16 __attribute__((ext_vector_type(16)));
constexpr int WREG = 16768;
constexpr int YROW = 80;
__device__ __forceinline__ float xhalf(float v) { return __shfl_xor(v, 32); }
__device__ __forceinline__ void zx_load(u32x4 (&z)[9], const bf16_t* ZXb, int t0, int lane) {
#pragma unroll
    for (int j = 0; j < 9; ++j) { int p = 64 * j + lane; p = p < 67 * 8 ? p : 67 * 8 - 1; const int row = p >> 3, c8 = p & 7, t = t0 - 3 + row; const u32x4 v = *(const u32x4*)(ZXb + (size_t)(t > 0 ? t : 0) * 512 + c8 * 8);
        const unsigned keep = t >= 0 ? 0xffffffffu : 0u; z[j] = (u32x4){v.x & keep, v.y & keep, v.z & keep, v.w & keep}; }
}
__device__ __forceinline__ void zx_park(const u32x4 (&z)[9], LAS unsigned char* ZT, int lane) {
#pragma unroll
    for (int j = 0; j < 9; ++j) { const int p = 64 * j + lane, row = p >> 3, c8 = p & 7; if (p < 67 * 8) *(LAS u32x4*)(ZT + row * 128 + ((c8 ^ (row & 7)) * 16)) = z[j]; }
}
__device__ __forceinline__ void item(const Frame& F, int l, int it) {
    int lane_ = F.lane; asm volatile("" : "+v"(lane_));
    const int b = it >> 4, n = (it >> 1) & 7, hc = it & 1, lane = lane_, w = F.wave, d1 = lane & 31, hi = lane >> 5, ch = 64 * n + 32 * hc + d1;
    LAS unsigned char* XCw = F.lds + w * WREG; LAS unsigned char* ZT = XCw + 8192; LAS unsigned char* YT = XCw;
    LAS float* comp = (LAS float*)(F.lds + 8 * WREG);
    LAS unsigned char* BfL = F.lds + 8 * WREG + 4096;
    LAS float* cwl = (LAS float*)(F.lds + RSTD_OFF);
    const bf16_t* ZXb = (const bf16_t*)(F.ws + WS_ZX) + (size_t)b * SEQ * 512 + 64 * n;
    __syncthreads();
    for (int i = F.tid; i < 320; i += 512) cwl[i] = i < 256 ? INP(F, IN_LCW)[(size_t)(l * 4 + (i >> 6)) * 512 + 64 * n + (i & 63)] : INP(F, IN_LCB)[l * 512 + 64 * n + (i - 256)];
    {   u32x4 z0[9]; zx_load(z0, ZXb, 64 * w, lane); zx_park(z0, ZT, lane); }
    {   const bf16_t* W = (const bf16_t*)(F.ws + WS_WTS + (size_t)l * WTS_LAYER + WO_LRUW) + (size_t)n * 128 * 64; const int gk = F.tid >> 6, gt = gk >> 2, ks = gk & 3;
        *(LAS bf16x8*)(BfL + F.tid * 16) = *(const bf16x8*)(W + (64 * gt + 32 * hc + d1) * 64 + 16 * ks + 8 * hi); }
    const float ba = INP(F, IN_LBA)[l * 512 + ch], bx = INP(F, IN_LBX)[l * 512 + ch], ls8l2 = -8.0f * LOG2E * log1pf(expf(-INP(F, IN_LLAM)[l * 512 + ch]));
    float hcarry = 0.f;
    __syncthreads();
    for (int sw = 0; sw < 4; ++sw) {
        const int t0 = 512 * sw + 64 * w;
        const bf16_t* ZYr = (const bf16_t*)(F.ws + WS_ZY) + ((size_t)b * SEQ + t0) * 512 + 64 * n + 32 * hc;
        u32x4 zyr[4];
#pragma unroll
        for (int j = 0; j < 4; ++j) zyr[j] = __builtin_nontemporal_load((const u32x4*)(ZYr + (size_t)(16 * j + (lane >> 2)) * 512 + (lane & 3) * 8));
#pragma unroll 1
        for (int c8 = 0; c8 < 8; ++c8) {
            float x3[8], x2[8], x1[8], x0[8];
            unpack8(*(const LAS u32x4*)(ZT + (lane + 0) * 128 + ((c8 ^ ((lane + 0) & 7)) * 16)), x3); unpack8(*(const LAS u32x4*)(ZT + (lane + 1) * 128 + ((c8 ^ ((lane + 1) & 7)) * 16)), x2);
            unpack8(*(const LAS u32x4*)(ZT + (lane + 2) * 128 + ((c8 ^ ((lane + 2) & 7)) * 16)), x1); unpack8(*(const LAS u32x4*)(ZT + (lane + 3) * 128 + ((c8 ^ ((lane + 3) & 7)) * 16)), x0);
            float o[8];
#pragma unroll
            for (int j = 0; j < 8; ++j) { const int c = c8 * 8 + j; o[j] = cwl[256 + c] + cwl[c] * x3[j] + cwl[64 + c] * x2[j] + cwl[128 + c] * x1[j] + cwl[192 + c] * x0[j]; }
            u32x4 pk; pk.x = pk2(o[0], o[1]); pk.y = pk2(o[2], o[3]); pk.z = pk2(o[4], o[5]); pk.w = pk2(o[6], o[7]);
            *(LAS u32x4*)(XCw + c8 * 1024 + lane * 16) = pk; }
        f32x16 acc[2][2];
#pragma unroll
        for (int tm = 0; tm < 2; ++tm) { acc[tm][0] = (f32x16){}; acc[tm][1] = (f32x16){}; }
#pragma unroll
        for (int ks = 0; ks < 4; ++ks) { const bf16x8 A0 = *(const LAS bf16x8*)(XCw + (2 * ks + hi) * 1024 + d1 * 16), A1 = *(const LAS bf16x8*)(XCw + (2 * ks + hi) * 1024 + (d1 + 32) * 16);
#pragma unroll
            for (int gt = 0; gt < 2; ++gt) { const bf16x8 Bq = *(const LAS bf16x8*)(BfL + ((gt * 4 + ks) * 64 + lane) * 16);
                acc[0][gt] = __builtin_amdgcn_mfma_f32_32x32x16_bf16(A0, Bq, acc[0][gt], 0, 0, 0); acc[1][gt] = __builtin_amdgcn_mfma_f32_32x32x16_bf16(A1, Bq, acc[1][gt], 0, 0, 0); } }
        float a[2][16], u[2][16]; float Ac = 1.f, Uc = 0.f;
        const int cx = 32 * hc + d1;
#pragma unroll
        for (int tm = 0; tm < 2; ++tm) {
#pragma unroll
            for (int r = 0; r < 16; ++r) { const int tok = 32 * tm + (r & 3) + 8 * (r >> 2) + 4 * hi;
                const float xcv = bf2f(*(const LAS bf16_t*)(XCw + (cx >> 3) * 1024 + tok * 16 + (cx & 7) * 2)), ra = acc[tm][0][r] + ba, ri = acc[tm][1][r] + bx;
                const float rr = __builtin_amdgcn_rcpf(1.0f + __builtin_amdgcn_exp2f(-LOG2E * ra)), ig = __builtin_amdgcn_rcpf(1.0f + __builtin_amdgcn_exp2f(-LOG2E * ri));
                a[tm][r] = __builtin_amdgcn_exp2f(ls8l2 * rr); u[tm][r] = __builtin_amdgcn_sqrtf(fmaxf(1.0f - a[tm][r] * a[tm][r], 0.f)) * (ig * xcv); }
#pragma unroll
            for (int i = 0; i < 4; ++i) {
                const float Ag = (a[tm][4 * i] * a[tm][4 * i + 1]) * (a[tm][4 * i + 2] * a[tm][4 * i + 3]);
                const float Ug = ((u[tm][4 * i] * a[tm][4 * i + 1] + u[tm][4 * i + 1]) * a[tm][4 * i + 2] + u[tm][4 * i + 2]) * a[tm][4 * i + 3] + u[tm][4 * i + 3];
                const float Agp = xhalf(Ag), Ugp = xhalf(Ug);
                const float A1 = hi ? Agp : Ag, U1 = hi ? Ugp : Ug, A2 = hi ? Ag : Agp, U2 = hi ? Ug : Ugp;
                Uc = A2 * (A1 * Uc + U1) + U2; Ac *= A1 * A2; }
        }
        LAS float* cb_ = comp + (sw & 1) * 512;
        if (hi == 0) *(LAS f32x2*)(cb_ + (w * 32 + d1) * 2) = (f32x2){Ac, Uc};
#pragma unroll
        for (int j = 0; j < 4; ++j) *(LAS u32x4*)(YT + (16 * j + (lane >> 2)) * YROW + (lane & 3) * 16) = zyr[j];
        u32x4 zn[9];
        if (sw < 3) zx_load(zn, ZXb, t0 + 512, lane);
        asm volatile("s_waitcnt lgkmcnt(0)" ::: "memory"); __builtin_amdgcn_s_barrier(); asm volatile("" ::: "memory");
        float h = hcarry, hin = 0.f;
#pragma unroll
        for (int w2 = 0; w2 < 8; ++w2) { const f32x2 cu = *(const LAS f32x2*)(cb_ + (w2 * 32 + d1) * 2); if (w2 == w) hin = h; h = cu.x * h + cu.y; }
        hcarry = h;
        h = hin;
#pragma unroll
        for (int tm = 0; tm < 2; ++tm) {
            float zyv[16];
#pragma unroll
            for (int q = 0; q < 16; ++q) zyv[q] = bf2f(*(const LAS bf16_t*)(YT + (32 * tm + 8 * (q >> 2) + 4 * hi + (q & 3)) * YROW + d1 * 2));
#pragma unroll
            for (int q = 0; q < 16; ++q) zyv[q] = gelu_tanh(zyv[q]);
#pragma unroll
            for (int i = 0; i < 4; ++i) {
                const float Ag = (a[tm][4 * i] * a[tm][4 * i + 1]) * (a[tm][4 * i + 2] * a[tm][4 * i + 3]);
                const float Ug = ((u[tm][4 * i] * a[tm][4 * i + 1] + u[tm][4 * i + 1]) * a[tm][4 * i + 2] + u[tm][4 * i + 2]) * a[tm][4 * i + 3] + u[tm][4 * i + 3];
                const float Agp = xhalf(Ag), Ugp = xhalf(Ug);
                const float A1 = hi ? Agp : Ag, U1 = hi ? Ugp : Ug, A2 = hi ? Ag : Agp, U2 = hi ? Ug : Ugp;
                const float hmid = A1 * h + U1; float hh = hi ? hmid : h; h = A2 * hmid + U2;
#pragma unroll
                for (int e = 0; e < 4; ++e) { hh = a[tm][4 * i + e] * hh + u[tm][4 * i + e]; const int tok = 32 * tm + 8 * i + 4 * hi + e;
                    LAS bf16_t* yp = (LAS bf16_t*)(YT + tok * YROW + d1 * 2); *yp = (bf16_t)f2bf(hh * zyv[4 * i + e]); } } }
        bf16_t* MX = (bf16_t*)(F.ws + WS_MIXED) + ((size_t)b * SEQ + t0) * D + 512 + 64 * n + 32 * hc;
#pragma unroll
        for (int j = 0; j < 4; ++j) *(u32x4*)(MX + (size_t)(16 * j + (lane >> 2)) * D + (lane & 3) * 8) = *(const LAS u32x4*)(YT + (16 * j + (lane >> 2)) * YROW + (lane & 3) * 16);
        {   float ss = 0.f;
#pragma unroll
            for (int j = 0; j < 4; ++j) { float v[8]; unpack8(*(const LAS u32x4*)(YT + lane * YROW + j * 16), v);
#pragma unroll
                for (int e = 0; e < 8; ++e) ss += v[e] * v[e]; }
            ((float*)(F.ws + WS_SSL))[((size_t)b * SEQ + t0 + lane) * 16 + 2 * n + hc] = ss; }
        if (sw < 3) zx_park(zn, ZT, lane);
    }
}
}

namespace cp {
typedef float f32x16 __attribute__((ext_vector_type(16)));
__device__ __forceinline__ void item(const Frame& F, int l, int it, unsigned* cmpdone) {
    int lane_ = F.lane; asm volatile("" : "+v"(lane_));
    const int kv = it >> 5, bg = (it >> 1) & 15, c0 = (it & 1) * 64, w = F.wave, lane = lane_, r32 = lane & 31, hi = lane >> 5;
    LAS unsigned char* lds = F.lds;
    const bf16_t* src = (const bf16_t*)(F.ws + WS_KV + (size_t)kv * KV_STRIDE) + (size_t)bg * SEQ * 64 + (size_t)(16 * (c0 + lane)) * 64 + w * 8;
    const bf16_t* W1F = (const bf16_t*)(F.ws + WS_WTS + (size_t)l * WTS_LAYER + WO_CW1) + ((size_t)(kv * 8 + w) * 128 * 64 + lane) * 8;
    __syncthreads();
    f32x16 acc[2]; acc[0] = (f32x16){}; acc[1] = (f32x16){};
    u32x4 sa[4]; bf16x8 Bf[4][4];
#pragma unroll
    for (int s4 = 0; s4 < 4; ++s4) { sa[s4] = *(const u32x4*)(src + (size_t)s4 * 64);
#pragma unroll
        for (int q = 0; q < 4; ++q) Bf[s4][q] = *(const bf16x8*)(W1F + (size_t)(4 * s4 + q) * 512); }
    *(LAS u32x4*)(lds + w * 1024 + lane * 16) = sa[0];
    LDS_WAIT(); __builtin_amdgcn_s_barrier(); asm volatile("" ::: "memory");
#pragma unroll 1
    for (int s4 = 0; s4 < 32; s4 += 4) {
#pragma unroll
        for (int j = 0; j < 4; ++j) { const int sl = s4 + j;
            LAS unsigned char* buf = lds + (sl & 1) * 8192;
#pragma unroll
            for (int q = 0; q < 4; ++q) { const bf16x8 A0 = *(const LAS bf16x8*)(buf + (2 * q + hi) * 1024 + r32 * 16), A1 = *(const LAS bf16x8*)(buf + (2 * q + hi) * 1024 + (r32 + 32) * 16);
                acc[0] = __builtin_amdgcn_mfma_f32_32x32x16_bf16(A0, Bf[j][q], acc[0], 0, 0, 0); acc[1] = __builtin_amdgcn_mfma_f32_32x32x16_bf16(A1, Bf[j][q], acc[1], 0, 0, 0); }
            if (sl + 1 < 32) *(LAS u32x4*)(lds + ((sl + 1) & 1) * 8192 + w * 1024 + lane * 16) = sa[(j + 1) & 3];
            if (sl + 4 < 32) { sa[j] = *(const u32x4*)(src + (size_t)(sl + 4) * 64);
#pragma unroll
                for (int q = 0; q < 4; ++q) Bf[j][q] = *(const bf16x8*)(W1F + (size_t)(4 * (sl + 4) + q) * 512); }
            LDS_WAIT(); __builtin_amdgcn_s_barrier(); asm volatile("" ::: "memory");
        }
    }
    {
        LAS unsigned char* H = lds + 16384; const int nn = 32 * w + r32; const float pb = ((const float*)(F.ws + WS_POSB))[(l * 2 + kv) * 256 + nn];
#pragma unroll
        for (int tm = 0; tm < 2; ++tm)
#pragma unroll
            for (int r = 0; r < 16; ++r) { const int c = 32 * tm + (r & 3) + 8 * (r >> 2) + 4 * hi; *(LAS bf16_t*)(H + (nn >> 3) * 1024 + c * 16 + (nn & 7) * 2) = (bf16_t)f2bf(gelu_tanh(acc[tm][r] + pb)); }
    }
    __syncthreads();
    if (w < 4) {
        const int tm = w & 1, dn = w >> 1, dd = 32 * dn + r32; const LAS unsigned char* H = lds + 16384;
        const bf16_t* W2 = (const bf16_t*)(F.ws + WS_WTS + (size_t)l * WTS_LAYER + WO_CW2) + ((size_t)kv * 64 + dd) * 256;
        f32x16 o = (f32x16){};
#pragma unroll
        for (int ks = 0; ks < 16; ++ks) { const bf16x8 A = *(const LAS bf16x8*)(H + (2 * ks + hi) * 1024 + (32 * tm + r32) * 16), B = *(const bf16x8*)(W2 + 16 * ks + 8 * hi);
            o = __builtin_amdgcn_mfma_f32_32x32x16_bf16(A, B, o, 0, 0, 0); }
        const float b2 = INP(F, IN_CB2)[(size_t)(l * 2 + kv) * 64 + dd];
        bf16_t* dst = (bf16_t*)(F.ws + WS_KCMP) + ((size_t)(kv * 16 + bg) * 128 + c0) * 64 + dd;
#pragma unroll
        for (int r = 0; r < 16; ++r) { const int c = 32 * tm + (r & 3) + 8 * (r >> 2) + 4 * hi; dst[(size_t)c * 64] = (bf16_t)f2bf(c0 + c < 127 ? o[r] + b2 : 0.f); }
    }
    asm volatile("s_waitcnt vmcnt(0)" ::: "memory"); __syncthreads();
    if (F.tid == 0) { __builtin_amdgcn_fence(__ATOMIC_RELEASE, "agent"); asm volatile("s_waitcnt vmcnt(0)" ::: "memory"); __hip_atomic_fetch_add(cmpdone + bg, 1u, __ATOMIC_RELAXED, __HIP_MEMORY_SCOPE_AGENT); }
}
}

__device__ __forceinline__ void fix_rows(const Frame& F, int l, int pm) {
    const float* gf = (const float*)(F.ws + WS_GFIRST); const float* gl = (const float*)(F.ws + WS_GLAST); const float* uf = (const float*)(F.ws + WS_UFIRST);
    const float* cw = (const float*)(F.ws + WS_FCW) + (size_t)l * 4 * FF; bf16_t* ACT = (bf16_t*)(F.ws + WS_ACT);
    for (int col = F.tid; col < FF; col += 512) {
        const float g0 = gf[((size_t)pm * 2) * FF + col], g1 = gf[((size_t)pm * 2 + 1) * FF + col]; float hm2 = 0.f, hm1 = 0.f;
        if (pm & 7) { hm2 = gl[((size_t)(pm - 1) * 2) * FF + col]; hm1 = gl[((size_t)(pm - 1) * 2 + 1) * FF + col]; }
        const float w0 = cw[col], w1 = cw[FF + col], w2 = cw[2 * FF + col], bb = cw[3 * FF + col];
        const float c0 = bb + w0 * hm2 + w1 * hm1 + w2 * g0, c1 = bb + w0 * hm1 + w1 * g0 + w2 * g1;
        ACT[((size_t)pm * 256) * FF + col] = (bf16_t)f2bf(siluf_(c0) * uf[((size_t)pm * 2) * FF + col]);
        ACT[((size_t)pm * 256 + 1) * FF + col] = (bf16_t)f2bf(siluf_(c1) * uf[((size_t)pm * 2 + 1) * FF + col]); }
}
__device__ __forceinline__ void ph_final(const Frame& F) {
    const float* rowss = (const float*)(F.ws + WS_ROWSS); const float* g = INP(F, IN_FING);
    for (int row = F.bid * 8 + F.wave; row < T; row += F.G * 8) {
        float s = F.lane < 16 ? rowss[(size_t)row * 16 + F.lane] : 0.f; s = wave_sum(s); const float rs = rsqrtf(s * (1.0f / D) + EPS);
#pragma unroll
        for (int j = 0; j < 4; ++j) { const int col = j * 256 + F.lane * 4; f32x4 v = *(const f32x4*)(F.out + (size_t)row * D + col); const f32x4 gv = *(const f32x4*)(g + col);
            v = v * rs * gv; *(f32x4*)(F.out + (size_t)row * D + col) = v; } }
}

constexpr int N_PHASES = 2 + 5 * NL;
#ifndef PH_MASK
#define PH_MASK 0xffff
#endif
#define PHON(b) ((PH_MASK >> (b)) & 1)
#ifndef REP_SUB
#define REP_SUB -1
#endif
#define REPS(k) (REP_SUB == (k) ? 2 : 1)
#ifndef FAST_WIN
#define FAST_WIN 1
#endif
#ifndef FAST_SEL
#define FAST_SEL 1
#endif
#define PH_FRAME() Frame F; { size_t z_ = 0; int t_, b_ = blockIdx.x, wv_ = wave0; asm volatile("" : "+s"(z_), "+s"(wv_), "+s"(b_)); \
        asm volatile("v_mbcnt_lo_u32_b32 %0, -1, 0\n\tv_mbcnt_hi_u32_b32 %0, -1, %0" : "=v"(t_)); t_ += wv_ * 64; \
        F.ws = args.ws + z_; F.out = args.out + z_; F.tid = t_; F.lane = t_ & 63; F.wave = __builtin_amdgcn_readfirstlane(t_ >> 6); F.bid = b_; F.G = gridDim.x; \
        F.lds = (LAS unsigned char*)lds_raw + (unsigned)z_; F.inl = (volatile LAS unsigned long long*)(F.lds + MISC_OFF); }
#define PHASE(k, ...) if (lo <= (k) && (k) < hi) { { PH_FRAME(); __VA_ARGS__ } if ((k) + 1 < hi) GRID_BAR(); }

template <int l> __device__ __forceinline__ void ph_win(const Frame& F) {
    unsigned char* wl = F.ws + WS_WTS + (size_t)l * WTS_LAYER;
    pg8::Gemm g{(const bf16_t*)(F.ws + WS_XG), (const bf16_t*)(wl + WO_WIN), T, NIN, D}; pg8::StaticOrder S; S.init(T, NIN, F.G, F.bid);
    EpiIn E{F.ws, l};
    pg8::gemm_phase<EpiIn, pg8::StaticOrder>(F.lds, F.lds + HALO_OFF, g, S, E);
}
constexpr int CW_QUEUE = 8192, CW_CMPDONE = 8448;
template <int l> __device__ __forceinline__ void ph_mix(const Frame& F) {
    unsigned* ctl = (unsigned*)(F.ws + WS_CTL); unsigned* qhead = ctl + CW_QUEUE + 64 * l; unsigned* cmpdone = ctl + CW_CMPDONE + 64 * l;
    volatile LAS unsigned* slot = (volatile LAS unsigned*)(F.lds + MISC_OFF + 248);
    for (;;) {
        __syncthreads();
        if (F.tid == 0) *slot = __hip_atomic_fetch_add(qhead, 1u, __ATOMIC_RELAXED, __HIP_MEMORY_SCOPE_AGENT);
        __syncthreads();
        const int it = (int)*slot;
        if (it >= 64 + 128 + 512) break;
        if (it < 64) { if (PHON(4)) cp::item(F, l, it, cmpdone); }
        else if (it < 192) { if (PHON(5)) lr::item(F, l, it - 64); }
        else { const int u = 511 - (it - 192); if (PHON(6)) at::unit(F, l, u & 15, u >> 4, cmpdone); }
    }
}
template <int l> __device__ __forceinline__ void ph_wout(const Frame& F) {
    unsigned char* wl = F.ws + WS_WTS + (size_t)l * WTS_LAYER;
    pg8::Gemm g{(const bf16_t*)(F.ws + WS_MIXED), (const bf16_t*)(wl + WO_WOUT), T, D, D}; pg8::StaticOrder S; S.init(T, D, F.G, F.bid);
    for (int rep_ = 0; rep_ < REPS(3); ++rep_) {
    EpiRes<true, l == 0> E{l == 0 ? (const void*)INP(F, IN_X) : (const void*)(F.ws + WS_XB), F.ws, l * NB * 6144 + 2048, (l * 2 + 1) * NB * D, rep_ ? 1 : 0};
    pg8::gemm_phase<EpiRes<true, l == 0>, pg8::StaticOrder>(F.lds, F.lds + HALO_OFF, g, S, E); }
}
template <int l> __device__ __forceinline__ void ph_ffn1(const Frame& F) {
    unsigned char* wl = F.ws + WS_WTS + (size_t)l * WTS_LAYER;
    pg8::Gemm g{(const bf16_t*)(F.ws + WS_XG), (const bf16_t*)(wl + WO_WGU), T, NGU, D}; pg8::StaticOrder S; S.init(T, NGU, F.G, F.bid, 2);
    EpiGU E{F.ws, l};
    pg8::gemm_phase<EpiGU, pg8::StaticOrder>(F.lds, F.lds + HALO_OFF, g, S, E);
}
template <int l> __device__ __forceinline__ void ph_ffn2(const Frame& F) {
    unsigned char* wl = F.ws + WS_WTS + (size_t)l * WTS_LAYER;
    pg8::Gemm g{(const bf16_t*)(F.ws + WS_ACT), (const bf16_t*)(wl + WO_WDN), T, D, FF}; pg8::StaticOrder S; S.init(T, D, F.G, F.bid);
    {   pg8::Unit u; for (int i = 0; S.next(i, u); ++i) fix_rows(F, l, u.pm);
        asm volatile("s_waitcnt vmcnt(0)" ::: "memory"); __syncthreads(); }
    if (l + 1 < NL) {
        for (int rep_ = REPS(5) - 1; rep_ >= 0; --rep_) {
        EpiRes<false, false> E{(const void*)(F.ws + WS_XB), F.ws, l * NB * 6144 + 5120, (l + 1) * 2 * NB * D, rep_ ? 2 : 0};
        pg8::gemm_phase<EpiRes<false, false>, pg8::StaticOrder>(F.lds, F.lds + HALO_OFF, g, S, E); }
    } else {
        EpiFinal E{(const bf16_t*)(F.ws + WS_XB), F.out, F.ws, l * NB * 6144 + 5120, INP(F, IN_FING)};
        pg8::gemm_phase<EpiFinal, pg8::StaticOrder>(F.lds, F.lds + HALO_OFF, g, S, E);
    }
}
#define LAYER(l) \
    PHASE(2 + 5 * (l) + 0, for (int rep_ = 0; rep_ < REPS(0); ++rep_) { if (PHON(3)) ph_win<l>(F); }) \
    PHASE(2 + 5 * (l) + 1, ph_mix<l>(F);) \
    PHASE(2 + 5 * (l) + 2, if (PHON(9)) ph_wout<l>(F);) \
    PHASE(2 + 5 * (l) + 3, for (int rep_ = 0; rep_ < REPS(4); ++rep_) { if (PHON(10)) ph_ffn1<l>(F); }) \
    PHASE(2 + 5 * (l) + 4, if (PHON(12)) ph_ffn2<l>(F);)

__global__ void __launch_bounds__(512, 2) fwd_kernel(Args args) {
    extern __shared__ __attribute__((aligned(16))) unsigned char lds_raw[];
    if (threadIdx.x == 0) { volatile LAS unsigned long long* inl = (volatile LAS unsigned long long*)((LAS unsigned char*)lds_raw + MISC_OFF);
#pragma unroll
        for (int i = 0; i < 29; ++i) inl[i] = (unsigned long long)args.in[i];
        inl[30] = 0ull;
#if MK_ONE_LAUNCH && !MK_CG_BARRIER
        (void)xb_add((unsigned*)(args.ws + WS_CTL) + 4096 + XB_XCNT(xb_xcc_id()), 1u);
#endif
    }
    __syncthreads();
#if MK_ONE_LAUNCH && MK_CG_BARRIER
    cg::grid_group grid = cg::this_grid();
#define GRID_BAR() grid.sync()
#elif MK_ONE_LAUNCH
    unsigned* xbar = (unsigned*)(args.ws + WS_CTL) + 4096;
    volatile LAS unsigned* xst = (volatile LAS unsigned*)((LAS unsigned char*)lds_raw + MISC_OFF + 240);
#define GRID_BAR() xcd_barrier(xbar, xst)
#else
#define GRID_BAR() do { } while (0)
#endif
    const int wave0 = __builtin_amdgcn_readfirstlane(threadIdx.x >> 6);
    const int lo = args.ph_lo, hi = args.ph_hi;
    PHASE(0, for (int rep_ = 0; rep_ < REPS(100); ++rep_) { if (PHON(0)) { ph_mod(F); ph_convert(F); ph_posp(F); } })
    PHASE(1, for (int rep_ = 0; rep_ < REPS(101); ++rep_) { if (PHON(1)) ph_prep(F); })
    LAYER(0) LAYER(1) LAYER(2) LAYER(3)
}

extern "C" void kernel_launch(void* const* d_in, const int* in_sizes, int n_in, void* d_out, int out_size, void* d_ws, size_t ws_size, hipStream_t stream) {
    static int grid = 0;
    if (grid == 0) {
        if (n_in != 29 || out_size != T * D || ws_size < WS_END) { fprintf(stderr, "kernel_launch: unexpected problem (n_in %d out %d ws %zu)\n", n_in, out_size, ws_size); grid = -1; return; }
        int dev = 0, cus = 0, per_cu = 0;
        hipGetDevice(&dev); hipDeviceGetAttribute(&cus, hipDeviceAttributeMultiprocessorCount, dev);
        if (hipFuncSetAttribute((const void*)fwd_kernel, hipFuncAttributeMaxDynamicSharedMemorySize, LDS_BYTES) != hipSuccess) { fprintf(stderr, "kernel_launch: hipFuncSetAttribute failed\n"); grid = -1; return; }
        hipOccupancyMaxActiveBlocksPerMultiprocessor(&per_cu, (const void*)fwd_kernel, 512, LDS_BYTES);
        (void)hipGetLastError();
        if (per_cu < 1) fprintf(stderr, "kernel_launch: occupancy query says %d\n", per_cu);
        grid = cus;
    }
    if (grid < 0) return;
    Args a{};
    for (int i = 0; i < 29; ++i) a.in[i] = (const float*)d_in[i];
    a.out = (float*)d_out; a.ws = (unsigned char*)d_ws;
#if MK_ONE_LAUNCH
    a.ph_lo = 0; a.ph_hi = N_PHASES;
#if MK_CG_BARRIER
    void* kargs[] = {&a};
    hipError_t e = hipLaunchCooperativeKernel((const void*)fwd_kernel, dim3(grid), dim3(512), kargs, LDS_BYTES, stream);
    if (e != hipSuccess) fprintf(stderr, "cooperative launch failed: %s\n", hipGetErrorString(e));
#else
    if (hipMemsetAsync((char*)d_ws + WS_CTL, 0, CTL_ZERO_BYTES, stream) != hipSuccess) { fprintf(stderr, "kernel_launch: memset failed\n"); return; }
    hipLaunchKernelGGL(fwd_kernel, dim3(grid), dim3(512), LDS_BYTES, stream, a);
#endif
#else
    for (int ph = 0; ph < N_PHASES; ++ph) { a.ph_lo = ph; a.ph_hi = ph + 1; hipLaunchKernelGGL(fwd_kernel, dim3(grid), dim3(512), LDS_BYTES, stream, a); }
#endif
}
```

```cpp
#include <hip/hip_runtime.h>
#include <cstdio>
#include <cstdint>

#ifndef MK_ONE_LAUNCH
#define MK_ONE_LAUNCH 1
#endif
#ifndef MK_CG_BARRIER
#define MK_CG_BARRIER 0
#endif
#if MK_ONE_LAUNCH && MK_CG_BARRIER
#include <hip/hip_cooperative_groups.h>
namespace cg = cooperative_groups;
#endif

#define LAS __attribute__((address_space(3)))
typedef unsigned short bf16_t;
typedef short bf16x8 __attribute__((ext_vector_type(8)));
typedef float f32x4 __attribute__((ext_vector_type(4)));
typedef float f32x2 __attribute__((ext_vector_type(2)));
typedef unsigned u32x4 __attribute__((ext_vector_type(4)));
typedef unsigned u32x2 __attribute__((ext_vector_type(2)));

constexpr int NB = 8, SEQ = 2048, T = NB * SEQ, D = 1024, NL = 4, FF = 2816;
constexpr int NIN = 2560;
constexpr int NINSRC = 2328;
constexpr int NGU = 2 * FF;
constexpr float EPS = 1e-6f;
constexpr float C2 = 0.125f * 1.4426950408889634f;
constexpr float LOG2E = 1.4426950408889634f;

constexpr size_t MiB = 1u << 20;
constexpr size_t WS_CTL = 0, CTL_ZERO_BYTES = 1 * MiB;
constexpr size_t WS_MOD = 1 * MiB;
constexpr size_t WS_SHW1 = 2 * MiB;
constexpr size_t WS_SHWG = 3 * MiB;
constexpr size_t WS_ROWSS = 4 * MiB;
constexpr size_t WS_SSN = 5 * MiB;
constexpr size_t WS_SSL = 6 * MiB;
constexpr size_t WS_LRUA = WS_SSL;
constexpr size_t WS_GS = 7 * MiB;
constexpr size_t WS_POSB = 7 * MiB + 512 * 1024;
constexpr size_t WS_POSP = 7 * MiB + 576 * 1024;
constexpr size_t WS_KCMP = 8 * MiB;
constexpr size_t WS_FCW = 9 * MiB;
constexpr size_t WS_GFIRST = 10 * MiB, WS_GLAST = 12 * MiB, WS_UFIRST = 14 * MiB;
constexpr size_t WS_ZG = 16 * MiB;
constexpr size_t WS_WTS = 20 * MiB, WTS_LAYER = 27 * MiB;
constexpr size_t WO_WIN = 0, WO_WOUT = 5 * MiB, WO_WGU = 7 * MiB, WO_WDN = 18 * MiB, WO_CW1 = 24 * MiB, WO_CW2 = 26 * MiB, WO_LRUW = 26 * MiB + 256 * 1024;
constexpr size_t WS_XG = 128 * MiB;
constexpr size_t WS_Q = 160 * MiB;
constexpr size_t WS_KV = 176 * MiB, KV_STRIDE = 5 * MiB;
constexpr size_t WS_ZX = 206 * MiB, WS_ZY = 222 * MiB;
constexpr size_t WS_OWIN = 238 * MiB;
constexpr size_t WS_MIXED = 254 * MiB;
constexpr size_t WS_ACT = 160 * MiB;
constexpr size_t WS_XB = 286 * MiB;
constexpr size_t WS_END = 318 * MiB;

constexpr int RING_BYTES = 131072, HALO_OFF = RING_BYTES, HALO_BYTES = 16384, MISC_OFF = HALO_OFF + HALO_BYTES, RSTD_OFF = MISC_OFF + 256, LDS_BYTES = RSTD_OFF + 1024 + 256;

__device__ __forceinline__ float bf2f(unsigned v) { return __uint_as_float(v << 16); }
__device__ __forceinline__ unsigned f2bf(float f) { unsigned u = __float_as_uint(f); return (u + 0x7fffu + ((u >> 16) & 1u)) >> 16; }
__device__ __forceinline__ unsigned pk2(float lo, float hi) { return f2bf(lo) | (f2bf(hi) << 16); }
__device__ __forceinline__ unsigned cvt_pk_bf16(float lo, float hi) { unsigned r; asm volatile("v_cvt_pk_bf16_f32 %0, %1, %2" : "=v"(r) : "v"(lo), "v"(hi)); return r; }
__device__ __forceinline__ void unpack8(const u32x4 v, float* o) {
    o[0] = __uint_as_float(v.x << 16); o[1] = __uint_as_float(v.x & 0xffff0000u); o[2] = __uint_as_float(v.y << 16); o[3] = __uint_as_float(v.y & 0xffff0000u);
    o[4] = __uint_as_float(v.z << 16); o[5] = __uint_as_float(v.z & 0xffff0000u); o[6] = __uint_as_float(v.w << 16); o[7] = __uint_as_float(v.w & 0xffff0000u);
}
__device__ __forceinline__ float sigmoidf_(float x) { return __builtin_amdgcn_rcpf(1.0f + __builtin_amdgcn_exp2f(-1.4426950408889634f * x)); }
__device__ __forceinline__ float siluf_(float x) { return x * __builtin_amdgcn_rcpf(1.0f + __builtin_amdgcn_exp2f(-1.4426950408889634f * x)); }
__device__ __forceinline__ float gelu_tanh(float x) { const float y2 = (2.0f * LOG2E * 0.7978845608028654f) * (x + 0.044715f * x * x * x); return x - x * __builtin_amdgcn_rcpf(1.0f + __builtin_amdgcn_exp2f(y2)); }
__device__ __forceinline__ float wave_sum(float v) {
#pragma unroll
    for (int o = 1; o < 64; o <<= 1) v += __shfl_xor(v, o);
    return v;
}
#define LDS_WAIT() asm volatile("s_waitcnt lgkmcnt(0)" ::: "memory")
__device__ __forceinline__ void st16_wt(void* p, const u32x4 v) { asm volatile("global_store_dwordx4 %0, %1, off sc1\n\ts_nop 1" :: "v"(p), "v"(v) : "memory"); }

namespace pg8 {
constexpr int BM = 256, BK = 64, HALF = 128, HTB = HALF * BK * 2, STAGE_BYTES = 8 * HTB, NXCD = 8, WGM = 4;
__host__ __device__ __forceinline__ int lds_byte(int r, int c) { const int st = (r >> 4) * 2 + (c >> 5), rr = r & 15, cc = c & 31, ob = rr * 64 + cc * 2; return st * 1024 + (ob ^ (((ob >> 9) & 1) << 5)); }
__host__ __device__ __forceinline__ void stage_rc(int b, int& R, int& C) { const int st = b / 1024, sb = b % 1024, swz = sb ^ (((sb >> 9) & 1) << 5); R = (st >> 1) * 16 + swz / 64; C = (st & 1) * 32 + (swz % 64) / 2; }
__host__ __device__ __forceinline__ int perm32(int rho) { const int n = rho >> 4, i = rho & 15; return 8 * (i >> 2) + 4 * n + (i & 3); }
struct Unit { int pm, pn; };
struct Gemm { const bf16_t* A; const bf16_t* Bt; int M, N, K; };
struct StaticOrder {
    int nM, nN, nwg, G, c, wgm;
    __host__ __device__ void init(int M, int N, int G_, int c_, int wgm_ = WGM) { nM = M / BM; nN = N / BM; nwg = nM * nN; G = G_; c = c_; wgm = wgm_; }
    __host__ __device__ bool next(int i, Unit& u) const {
        const long L = (long)i * G + c; if (L >= nwg) return false;
        int wgid = (int)L; { const int q = nwg / NXCD, r = nwg % NXCD, xcd = wgid % NXCD, off = wgid / NXCD; wgid = (xcd < r ? xcd * (q + 1) : r * (q + 1) + (xcd - r) * q) + off; }
        const int nig = wgm * nN, gid = wgid / nig, fm = gid * wgm, gsz = (nM - fm) < wgm ? (nM - fm) : wgm;
        u.pm = fm + ((wgid % nig) % gsz); u.pn = (wgid % nig) / gsz; return true;
    }
};
template <class Epi, class Sched, bool ALIGN_EPI = true, bool SP2 = true>
__device__ __forceinline__ void gemm_phase(LAS unsigned char* lds, LAS unsigned char* ldsx, const Gemm g, const Sched& S, const Epi& E) {
    int tid_ = threadIdx.x; asm volatile("" : "+v"(tid_));
    const int tid = tid_, wid = __builtin_amdgcn_readfirstlane(tid >> 6), lane = tid & 63, wr = wid >> 2, wc = wid & 3, fr = lane & 15, fq = lane >> 4;
    const int K = g.K, nt = K / BK;
    unsigned voffA[2], voffB[2];
#pragma unroll
    for (int i = 0; i < 2; ++i) { int R, C; stage_rc(tid * 16 + i * 8192, R, C); const int Rb = Epi::PERM ? ((R & ~31) + perm32(R & 31)) : R;
        voffA[i] = (unsigned)(R * K + C) * 2u; voffB[i] = (unsigned)(Rb * K + C) * 2u; }
    const size_t kstep = (size_t)(BK * 2);
    const size_t hstep = (size_t)HALF * K * 2;
    const size_t tstep = 2 * hstep;
    const unsigned ldsw = (unsigned)wid * 1024u;
    const int aoff = lds_byte(wr * 64 + fr, fq * 8), boff = lds_byte(wc * 32 + fr, fq * 8);
#define PG8_SA(b, h) (((b) * 2 + (h)) * HTB)
#define PG8_SB(b, h) ((4 + (b) * 2 + (h)) * HTB)
#define PG8_STAGE(bufoff, gbase, voff) do { _Pragma("unroll") for (int _i = 0; _i < 2; ++_i) \
        __builtin_amdgcn_global_load_lds((const unsigned*)((const char*)(gbase) + (voff)[_i]), (LAS unsigned*)(lds + (bufoff) + ldsw + _i * 8192), 16, 0, 0); } while (0)
#define PG8_LDA(dst, b, h) do { _Pragma("unroll") for (int m = 0; m < 4; ++m) _Pragma("unroll") for (int k = 0; k < 2; ++k) dst[m][k] = *(const LAS bf16x8*)(lds + PG8_SA(b, h) + aoff + m * 2048 + k * 1024); } while (0)
#define PG8_LDB(dst, b, h) do { _Pragma("unroll") for (int n = 0; n < 2; ++n) _Pragma("unroll") for (int k = 0; k < 2; ++k) dst[n][k] = *(const LAS bf16x8*)(lds + PG8_SB(b, h) + boff + n * 2048 + k * 1024); } while (0)
#define PG8_MMA(ai, bj, At, Bt) do { __builtin_amdgcn_s_setprio(1); _Pragma("unroll") for (int m = 0; m < 4; ++m) _Pragma("unroll") for (int n = 0; n < 2; ++n) _Pragma("unroll") for (int k = 0; k < 2; ++k) \
        acc[ai][bj][m][n] = __builtin_amdgcn_mfma_f32_16x16x32_bf16(Bt[n][k], At[m][k], acc[ai][bj][m][n], 0, 0, 0); __builtin_amdgcn_s_setprio(0); } while (0)
#define PG8_WAIT_V(n) asm volatile("s_waitcnt vmcnt(" #n ")" ::: "memory")
#define PG8_WAIT_L(n) asm volatile("s_waitcnt lgkmcnt(" #n ")" ::: "memory")
#define PG8_BAR __builtin_amdgcn_s_barrier()
#define PG8_SCHED __builtin_amdgcn_sched_barrier(0)
    Unit cur, nxt; int ui = 0;
    if (!S.next(0, cur)) return;
    f32x4 acc[2][2][4][2];
#pragma unroll
    for (int a = 0; a < 2; ++a)
#pragma unroll
        for (int b = 0; b < 2; ++b)
#pragma unroll
            for (int m = 0; m < 4; ++m)
#pragma unroll
                for (int n = 0; n < 2; ++n) acc[a][b][m][n] = (f32x4){0.f, 0.f, 0.f, 0.f};
    bf16x8 At[4][2], B0[2][2], B1[2][2];
    const char* cA = (const char*)g.A + (size_t)cur.pm * tstep; const char* cB = (const char*)g.Bt + (size_t)cur.pn * tstep;
    typename Epi::PreRegs pregs;
    if constexpr (Epi::PRE) E.pre_issue(pregs, cur.pm, wid, lane);
    if constexpr (SP2) {
        PG8_STAGE(PG8_SB(0, 0), cB, voffB); PG8_STAGE(PG8_SB(0, 1), cB + hstep, voffB); PG8_STAGE(PG8_SA(0, 0), cA, voffA); PG8_STAGE(PG8_SA(0, 1), cA + hstep, voffA);
        if (wr == 1) PG8_BAR;
        PG8_WAIT_V(2); PG8_BAR;
        if constexpr (Epi::PRE) E.pre_commit(pregs, ldsx, wid, lane);
        PG8_STAGE(PG8_SB(1, 0), cB + kstep, voffB); PG8_STAGE(PG8_SA(1, 0), cA + kstep, voffA); PG8_STAGE(PG8_SB(1, 1), cB + hstep + kstep, voffB);
        PG8_WAIT_V(6); PG8_BAR;
    } else {
        PG8_STAGE(PG8_SB(0, 0), cB, voffB); PG8_STAGE(PG8_SA(0, 0), cA, voffA); PG8_STAGE(PG8_SB(0, 1), cB + hstep, voffB); PG8_STAGE(PG8_SA(0, 1), cA + hstep, voffA);
        if (wr == 1) PG8_BAR;
        PG8_WAIT_V(4); PG8_BAR;
        if constexpr (Epi::PRE) E.pre_commit(pregs, ldsx, wid, lane);
        PG8_STAGE(PG8_SB(1, 0), cB + kstep, voffB); PG8_STAGE(PG8_SA(1, 0), cA + kstep, voffA); PG8_STAGE(PG8_SB(1, 1), cB + hstep + kstep, voffB);
        PG8_WAIT_V(6); PG8_BAR;
    }
    for (;;) {
        const bool has_next = S.next(ui + 1, nxt);
        const char* nA = has_next ? (const char*)g.A + (size_t)nxt.pm * tstep : cA; const char* nB = has_next ? (const char*)g.Bt + (size_t)nxt.pn * tstep : cB;
        for (int t = 0; t < nt; t += 2) {
            const bool last = (t == nt - 2);
            const char* a1 = cA + (size_t)(t + 1) * kstep;
            const char* a2 = last ? nA : cA + (size_t)(t + 2) * kstep; const char* b2 = last ? nB : cB + (size_t)(t + 2) * kstep;
            const char* a3 = a2 + kstep; const char* b3 = b2 + kstep;
            if constexpr (Epi::MIDK) { if (t == (nt >> 1)) E.midk(acc, cur, wr, fr, ldsx); }
            if constexpr (SP2) {
            PG8_LDB(B0, 0, 0); PG8_LDB(B1, 0, 1); PG8_SCHED; PG8_LDA(At, 0, 0); PG8_STAGE(PG8_SA(1, 1), a1 + hstep, voffA);
            PG8_WAIT_V(8); PG8_WAIT_L(0); PG8_BAR; PG8_MMA(0, 0, At, B0); PG8_MMA(0, 1, At, B1); PG8_BAR; PG8_SCHED;
            PG8_LDA(At, 0, 1); PG8_STAGE(PG8_SB(0, 0), b2, voffB); PG8_STAGE(PG8_SB(0, 1), b2 + hstep, voffB); PG8_STAGE(PG8_SA(0, 0), a2, voffA);
            PG8_WAIT_V(8); PG8_WAIT_L(0); PG8_BAR; PG8_MMA(1, 0, At, B0); PG8_MMA(1, 1, At, B1); PG8_BAR; PG8_SCHED;
            PG8_LDB(B0, 1, 0); PG8_LDB(B1, 1, 1); PG8_SCHED; PG8_LDA(At, 1, 0); PG8_STAGE(PG8_SA(0, 1), a2 + hstep, voffA);
            PG8_WAIT_V(8); PG8_WAIT_L(0); PG8_BAR; PG8_MMA(0, 0, At, B0); PG8_MMA(0, 1, At, B1); PG8_BAR; PG8_SCHED;
            PG8_LDA(At, 1, 1); PG8_STAGE(PG8_SB(1, 0), b3, voffB); PG8_STAGE(PG8_SB(1, 1), b3 + hstep, voffB); PG8_STAGE(PG8_SA(1, 0), a3, voffA);
            PG8_WAIT_V(8); PG8_WAIT_L(0); PG8_BAR; PG8_MMA(1, 0, At, B0); PG8_MMA(1, 1, At, B1); PG8_BAR; PG8_SCHED;
            } else {
            PG8_LDB(B0, 0, 0); PG8_SCHED; PG8_LDA(At, 0, 0); PG8_STAGE(PG8_SA(1, 1), a1 + hstep, voffA);
            PG8_WAIT_L(8); PG8_BAR; PG8_WAIT_L(0); PG8_MMA(0, 0, At, B0); PG8_BAR; PG8_SCHED;
            PG8_LDB(B1, 0, 1); PG8_STAGE(PG8_SB(0, 0), b2, voffB);
            PG8_BAR; PG8_WAIT_L(0); PG8_MMA(0, 1, At, B1); PG8_BAR;
            PG8_LDA(At, 0, 1); PG8_STAGE(PG8_SA(0, 0), a2, voffA);
            PG8_BAR; PG8_WAIT_L(0); PG8_MMA(1, 0, At, B0); PG8_BAR; PG8_SCHED;
            PG8_STAGE(PG8_SB(0, 1), b2 + hstep, voffB);
            PG8_WAIT_V(6); PG8_BAR; PG8_MMA(1, 1, At, B1); PG8_BAR;
            PG8_LDB(B0, 1, 0); PG8_SCHED; PG8_LDA(At, 1, 0); PG8_STAGE(PG8_SA(0, 1), a2 + hstep, voffA);
            PG8_WAIT_L(8); PG8_BAR; PG8_WAIT_L(0); PG8_MMA(0, 0, At, B0); PG8_BAR; PG8_SCHED;
            PG8_LDB(B1, 1, 1); PG8_STAGE(PG8_SB(1, 0), b3, voffB);
            PG8_BAR; PG8_WAIT_L(0); PG8_MMA(0, 1, At, B1); PG8_BAR;
            PG8_LDA(At, 1, 1); PG8_STAGE(PG8_SA(1, 0), a3, voffA);
            PG8_BAR; PG8_WAIT_L(0); PG8_MMA(1, 0, At, B0); PG8_BAR; PG8_SCHED;
            PG8_STAGE(PG8_SB(1, 1), b3 + hstep, voffB);
            PG8_WAIT_V(6); PG8_BAR; PG8_MMA(1, 1, At, B1); PG8_BAR;
            }
        }
        if constexpr (ALIGN_EPI) { if (wr == 0) PG8_BAR; }
        E(acc, cur, wr, wc, fr, fq, ldsx, wid, lane, ui & 1, has_next ? nxt.pm : -1);
        if (!has_next) break;
#pragma unroll
        for (int a = 0; a < 2; ++a)
#pragma unroll
            for (int b = 0; b < 2; ++b)
#pragma unroll
                for (int m = 0; m < 4; ++m)
#pragma unroll
                    for (int n = 0; n < 2; ++n) acc[a][b][m][n] = (f32x4){0.f, 0.f, 0.f, 0.f};
        cur = nxt; cA = nA; cB = nB; ++ui;
        if constexpr (ALIGN_EPI) { if (wr == 1) PG8_BAR; }
    }
    PG8_WAIT_V(0);
    if constexpr (!ALIGN_EPI) { if (wr == 0) PG8_BAR; }
    PG8_BAR;
#undef PG8_SA
#undef PG8_SB
#undef PG8_STAGE
#undef PG8_LDA
#undef PG8_LDB
#undef PG8_MMA
#undef PG8_WAIT_V
#undef PG8_WAIT_L
#undef PG8_BAR
#undef PG8_SCHED
}
}

__device__ __forceinline__ float row_rstd(const float* rowss, int row, int fq) {
    const f32x4 p = *(const f32x4*)(rowss + (size_t)row * 16 + fq * 4);
    float s = (p.x + p.y) + (p.z + p.w);
    s += __shfl_xor(s, 16); s += __shfl_xor(s, 32);
    return rsqrtf(s * (1.0f / D) + EPS);
}

struct RstdAhead { f32x4 v0, v1; };
__device__ __forceinline__ void rstd_issue(RstdAhead& r, const float* rowss, int pm, int tid) {
    const float* p = rowss + ((size_t)pm * 256 + (tid >> 2)) * 16 + (tid & 3) * 4; r.v0 = *(const f32x4*)p; r.v1 = *(const f32x4*)(p + 128 * 16);
}
__device__ __forceinline__ void rstd_commit(const RstdAhead& r, LAS float* tab, int tid) {
    float s0 = (r.v0.x + r.v0.y) + (r.v0.z + r.v0.w), s1 = (r.v1.x + r.v1.y) + (r.v1.z + r.v1.w);
    s0 += __shfl_xor(s0, 1); s1 += __shfl_xor(s1, 1); s0 += __shfl_xor(s0, 2); s1 += __shfl_xor(s1, 2);
    if ((tid & 3) == 0) { tab[tid >> 2] = rsqrtf(s0 * (1.0f / D) + EPS); tab[128 + (tid >> 2)] = rsqrtf(s1 * (1.0f / D) + EPS); }
}
__device__ __forceinline__ void rstd_pre(const float* rowss, int pm, LAS unsigned char* ldsx, int wid, int lane) {
    RstdAhead r; rstd_issue(r, rowss, pm, wid * 64 + lane); rstd_commit(r, (LAS float*)(ldsx + 4096), wid * 64 + lane);
    LDS_WAIT(); __builtin_amdgcn_s_barrier(); asm volatile("" ::: "memory");
}
__device__ __forceinline__ LAS float* rstd_table(const float* rowss, int pm, LAS unsigned char* ldsx, int wid, int lane) {
    LAS float* tab = (LAS float*)(ldsx + (RSTD_OFF - HALO_OFF));
    if (wid < 4) { const int r = wid * 64 + lane; const f32x4* p = (const f32x4*)(rowss + ((size_t)pm * 256 + r) * 16); const f32x4 a = p[0], b = p[1], c = p[2], d = p[3];
        const float sm = ((a.x + a.y) + (a.z + a.w)) + ((b.x + b.y) + (b.z + b.w)) + ((c.x + c.y) + (c.z + c.w)) + ((d.x + d.y) + (d.z + d.w));
        tab[r] = rsqrtf(sm * (1.0f / D) + EPS); }
    LDS_WAIT(); __builtin_amdgcn_s_barrier(); asm volatile("" ::: "memory");
    return tab;
}

struct EpiIn {
    static constexpr bool PERM = true, MIDK = false, PRE = true;
    unsigned char* ws; int l;
    typedef RstdAhead PreRegs;
    __device__ __forceinline__ void pre_issue(PreRegs& r, int pm, int wid, int lane) const { rstd_issue(r, (const float*)(ws + WS_ROWSS), pm, wid * 64 + lane); }
    __device__ __forceinline__ void pre_commit(const PreRegs& r, LAS unsigned char* ldsx, int wid, int lane) const { rstd_commit(r, (LAS float*)(ldsx + 4096), wid * 64 + lane); }
    __device__ __forceinline__ void operator()(const f32x4 (&acc)[2][2][4][2], const pg8::Unit& u, int wr, int wc, int fr, int fq, LAS unsigned char* ldsx, int wid, int lane, int par, int nxt_pm) const {
        asm volatile("" : "+v"(fr), "+v"(fq), "+v"(lane));
        RstdAhead ra; if (nxt_pm >= 0) rstd_issue(ra, (const float*)(ws + WS_ROWSS), nxt_pm, wid * 64 + lane);
        const float* shw = (const float*)(ws + WS_SHW1) + (size_t)l * NB * NIN; bf16_t* Q = (bf16_t*)(ws + WS_Q); bf16_t* KV = (bf16_t*)(ws + WS_KV);
        bf16_t* ZX = (bf16_t*)(ws + WS_ZX); bf16_t* ZY = (bf16_t*)(ws + WS_ZY); float* ZG = (float*)(ws + WS_ZG);
        const int b = u.pm >> 3, cin = wc * 32 + 8 * fq, row0 = u.pm * 256 + wr * 64 + fr;
        f32x4 bv[2][2];
#pragma unroll
        for (int bj = 0; bj < 2; ++bj)
#pragma unroll
            for (int n = 0; n < 2; ++n) bv[bj][n] = *(const f32x4*)(shw + b * NIN + u.pn * 256 + bj * 128 + cin + 4 * n);
        const LAS float* rtab = (const LAS float*)(ldsx + 4096 + 1024 * par);
#pragma unroll
        for (int ai = 0; ai < 2; ++ai)
#pragma unroll
            for (int m = 0; m < 4; ++m) {
                const int row = row0 + ai * 128 + m * 16;
                const float rs = rtab[ai * 128 + wr * 64 + m * 16 + fr];
#pragma unroll
                for (int bj = 0; bj < 2; ++bj) {
                    f32x4 v0 = acc[ai][bj][m][0] * rs + bv[bj][0], v1 = acc[ai][bj][m][1] * rs + bv[bj][1];
                    const int col = u.pn * 256 + bj * 128 + cin;
                    if (u.pn < 2) { v0 = v0 * C2; v1 = v1 * C2; }
                    u32x4 w; w.x = cvt_pk_bf16(v0[0], v0[1]); w.y = cvt_pk_bf16(v0[2], v0[3]); w.z = cvt_pk_bf16(v1[0], v1[1]); w.w = cvt_pk_bf16(v1[2], v1[3]);
                    if (u.pn < 2) st16_wt(Q + (size_t)row * 512 + col, w);
                    else if (u.pn < 5) { const int c2 = col - 512, arr = c2 >> 7, wi = c2 & 127, g = wi >> 6, d = wi & 63, t = row & (SEQ - 1);
                        st16_wt(KV + (size_t)arr * (KV_STRIDE / 2) + ((size_t)((b * 2 + g) * SEQ + t) * 64 + d), w); }
                    else if (u.pn < 7) st16_wt(ZX + (size_t)row * 512 + (col - 1280), w);
                    else if (u.pn < 9) st16_wt(ZY + (size_t)row * 512 + (col - 1792), w);
                    else { const int c = col - 2304; if (c < 24) { *(f32x4*)(ZG + (size_t)row * 24 + c) = v0; *(f32x4*)(ZG + (size_t)row * 24 + c + 4) = v1; } }
                }
            }
        if (nxt_pm >= 0) rstd_commit(ra, (LAS float*)(ldsx + 4096 + 1024 * (par ^ 1)), wid * 64 + lane);
    }
};

template <bool MIDK_, bool BF32> struct EpiRes {
    static constexpr bool PERM = true, MIDK = MIDK_, PRE = MIDK_;
    struct PreRegs { f32x2 sn; f32x4 a, b, c, d; };
    __device__ __forceinline__ void pre_issue(PreRegs& r, int pm, int wid, int lane) const { const int t = wid * 64 + lane; const size_t row = (size_t)pm * 256 + (t & 255);
        r.sn = *(const f32x2*)((const float*)(ws + WS_SSN) + row * 2); const f32x4* pl = (const f32x4*)((const float*)(ws + WS_SSL) + row * 16); r.a = pl[0]; r.b = pl[1]; r.c = pl[2]; r.d = pl[3]; }
    __device__ __forceinline__ void pre_commit(const PreRegs& r, LAS unsigned char* ldsx, int wid, int lane) const { const int t = wid * 64 + lane;
        const float sl = ((r.a.x + r.a.y) + (r.a.z + r.a.w)) + ((r.b.x + r.b.y) + (r.b.z + r.b.w)) + ((r.c.x + r.c.y) + (r.c.z + r.c.w)) + ((r.d.x + r.d.y) + (r.d.z + r.d.w));
        const float rn = rsqrtf((r.sn.x + r.sn.y) * (1.0f / 512.0f) + EPS), rl = rsqrtf(sl * (1.0f / 512.0f) + EPS);
        if (t < 256) ((LAS f32x2*)ldsx)[t] = (f32x2){rn / rl, rl}; }
    const void* base; unsigned char* ws; int goff; int gsoff; int dry;
    __device__ __forceinline__ void midk(f32x4 (&acc)[2][2][4][2], const pg8::Unit& u, int wr, int fr, LAS unsigned char* ldsx) const {
        asm volatile("" : "+v"(fr));
        const LAS f32x2* rs2 = (const LAS f32x2*)ldsx;
#pragma unroll
        for (int ai = 0; ai < 2; ++ai)
#pragma unroll
            for (int m = 0; m < 4; ++m) { const float s = rs2[ai * 128 + wr * 64 + m * 16 + fr].x;
#pragma unroll
                for (int bj = 0; bj < 2; ++bj)
#pragma unroll
                    for (int n = 0; n < 2; ++n) acc[ai][bj][m][n] = acc[ai][bj][m][n] * s; }
    }
    __device__ __forceinline__ void operator()(const f32x4 (&acc)[2][2][4][2], const pg8::Unit& u, int wr, int wc, int fr, int fq, LAS unsigned char* ldsx, int, int, int, int) const {
        run(acc, u, wr, wc, fr, fq, ldsx, dry);
#if REP_SUB == 7
        run(acc, u, wr, wc, fr, fq, ldsx, MIDK ? 1 : 2);
#endif
    }
    __device__ __forceinline__ void run(const f32x4 (&acc)[2][2][4][2], const pg8::Unit& u, int wr, int wc, int fr, int fq, LAS unsigned char* ldsx, int dry) const {
        asm volatile("" : "+v"(fr), "+v"(fq));
        const LAS f32x2* rs2 = (const LAS f32x2*)ldsx;
        const float* gate = (const float*)(ws + WS_MOD) + goff; const float* gsn = (const float*)(ws + WS_GS) + gsoff;
        bf16_t* XG = (bf16_t*)(ws + (dry ? (dry == 1 ? WS_ZX : WS_MIXED) : WS_XG)); bf16_t* XB = (bf16_t*)(ws + (dry ? (dry == 1 ? WS_Q : WS_MIXED) : WS_XB)); float* rowss = (float*)(ws + (dry ? WS_LRUA : WS_ROWSS));
        const float* basef = (const float*)base; const bf16_t* baseb = (const bf16_t*)base;
        const int b = u.pm >> 3, col0 = u.pn * 256 + wc * 32 + 8 * fq;
        f32x4 gv[2][2], gs[2][2];
#pragma unroll
        for (int bj = 0; bj < 2; ++bj)
#pragma unroll
            for (int n = 0; n < 2; ++n) { gv[bj][n] = *(const f32x4*)(gate + (size_t)b * 6144 + col0 + bj * 128 + n * 4); gs[bj][n] = *(const f32x4*)(gsn + (size_t)b * D + col0 + bj * 128 + n * 4); }
        f32x4 pre[2][2][2]; u32x4 prb[4][2];
        {   const size_t off0 = (size_t)(u.pm * 256 + wr * 64 + fr) * D + col0;
            if constexpr (BF32) {
#pragma unroll
                for (int bj = 0; bj < 2; ++bj) { pre[0][bj][0] = *(const f32x4*)(basef + off0 + bj * 128); pre[0][bj][1] = *(const f32x4*)(basef + off0 + bj * 128 + 4); }
            } else {
#pragma unroll
                for (int g8 = 0; g8 < 4; ++g8)
#pragma unroll
                    for (int bj = 0; bj < 2; ++bj) prb[g8][bj] = *(const u32x4*)(baseb + off0 + (size_t)(g8 * 16) * D + bj * 128);
            } }
#pragma unroll
        for (int gi = 0; gi < 8; ++gi) {
            const int ai = gi >> 2, m = gi & 3;
            const int row = u.pm * 256 + ai * 128 + wr * 64 + m * 16 + fr; const size_t off = (size_t)row * D + col0; float ss = 0.f;
            const float rl = MIDK ? rs2[ai * 128 + wr * 64 + m * 16 + fr].y : 1.0f;
            if constexpr (BF32) { if (gi < 7) { const int ai2 = (gi + 1) >> 2, m2 = (gi + 1) & 3; const size_t off2 = (size_t)(u.pm * 256 + ai2 * 128 + wr * 64 + m2 * 16 + fr) * D + col0;
#pragma unroll
                for (int bj = 0; bj < 2; ++bj) { pre[(gi + 1) & 1][bj][0] = *(const f32x4*)(basef + off2 + bj * 128); pre[(gi + 1) & 1][bj][1] = *(const f32x4*)(basef + off2 + bj * 128 + 4); } } }
#pragma unroll
            for (int bj = 0; bj < 2; ++bj) {
                f32x4 r0, r1;
                if constexpr (BF32) { r0 = pre[gi & 1][bj][0]; r1 = pre[gi & 1][bj][1]; }
                else { const u32x4 v = prb[gi & 3][bj]; r0 = (f32x4){__uint_as_float(v.x << 16), __uint_as_float(v.x & 0xffff0000u), __uint_as_float(v.y << 16), __uint_as_float(v.y & 0xffff0000u)};
                    r1 = (f32x4){__uint_as_float(v.z << 16), __uint_as_float(v.z & 0xffff0000u), __uint_as_float(v.w << 16), __uint_as_float(v.w & 0xffff0000u)};
                    if (gi < 4) prb[gi & 3][bj] = *(const u32x4*)(baseb + (size_t)(u.pm * 256 + 128 + wr * 64 + gi * 16 + fr) * D + col0 + bj * 128); }
                const f32x4 x0 = r0 + gv[bj][0] * (MIDK ? acc[ai][bj][m][0] * rl : acc[ai][bj][m][0]), x1 = r1 + gv[bj][1] * (MIDK ? acc[ai][bj][m][1] * rl : acc[ai][bj][m][1]);
                ss += ((x0[0] * x0[0] + x0[1] * x0[1]) + (x0[2] * x0[2] + x0[3] * x0[3])) + ((x1[0] * x1[0] + x1[1] * x1[1]) + (x1[2] * x1[2] + x1[3] * x1[3]));
                u32x4 w; w.x = cvt_pk_bf16(x0[0], x0[1]); w.y = cvt_pk_bf16(x0[2], x0[3]); w.z = cvt_pk_bf16(x1[0], x1[1]); w.w = cvt_pk_bf16(x1[2], x1[3]);
                *(u32x4*)(XB + off + bj * 128) = w;
                const f32x4 y0 = x0 * gs[bj][0], y1 = x1 * gs[bj][1];
                u32x4 wg; wg.x = cvt_pk_bf16(y0[0], y0[1]); wg.y = cvt_pk_bf16(y0[2], y0[3]); wg.z = cvt_pk_bf16(y1[0], y1[1]); wg.w = cvt_pk_bf16(y1[2], y1[3]);
                *(u32x4*)(XG + off + bj * 128) = wg; }
            ss += __shfl_xor(ss, 16); ss += __shfl_xor(ss, 32);
            if (fq == 0) rowss[(size_t)row * 16 + u.pn * 4 + wc] = ss;
            asm volatile("" ::: "memory");
        }
    }
};

constexpr int CW_PANEL = 9216;
struct EpiFinal {
    static constexpr bool PERM = false, MIDK = false, PRE = false;
    struct PreRegs {};
    const bf16_t* base; float* out; unsigned char* ws; int goff; const float* fg;
    __device__ __forceinline__ void operator()(f32x4 (&acc)[2][2][4][2], const pg8::Unit& u, int wr, int wc, int fr, int fq, LAS unsigned char* ldsx, int wid, int lane, int, int) const {
        asm volatile("" : "+v"(fr), "+v"(fq), "+v"(lane));
        const float* gate = (const float*)(ws + WS_MOD) + goff; float* rowss = (float*)(ws + WS_ROWSS); unsigned* pcnt = (unsigned*)(ws + WS_CTL) + CW_PANEL + 64 * u.pm;
        const int b = u.pm >> 3, col0 = u.pn * 256 + wc * 32 + 4 * fq;
        {   f32x4 gv[2][2];
#pragma unroll
            for (int bj = 0; bj < 2; ++bj)
#pragma unroll
                for (int n = 0; n < 2; ++n) gv[bj][n] = *(const f32x4*)(gate + (size_t)b * 6144 + col0 + bj * 128 + n * 16);
            u32x2 pre[2][2][2];
#pragma unroll
            for (int bj = 0; bj < 2; ++bj)
#pragma unroll
                for (int n = 0; n < 2; ++n) pre[0][bj][n] = *(const u32x2*)(base + (size_t)(u.pm * 256 + wr * 64 + fr) * D + col0 + bj * 128 + n * 16);
#pragma unroll
            for (int gi = 0; gi < 8; ++gi) {
                const int ai = gi >> 2, m = gi & 3; const int row = u.pm * 256 + ai * 128 + wr * 64 + m * 16 + fr; float ss = 0.f;
                if (gi < 7) { const int ai2 = (gi + 1) >> 2, m2 = (gi + 1) & 3; const size_t off2 = (size_t)(u.pm * 256 + ai2 * 128 + wr * 64 + m2 * 16 + fr) * D + col0;
#pragma unroll
                    for (int bj = 0; bj < 2; ++bj)
#pragma unroll
                        for (int n = 0; n < 2; ++n) pre[(gi + 1) & 1][bj][n] = *(const u32x2*)(base + off2 + bj * 128 + n * 16); }
#pragma unroll
                for (int bj = 0; bj < 2; ++bj)
#pragma unroll
                    for (int n = 0; n < 2; ++n) { const u32x2 v = pre[gi & 1][bj][n]; const f32x4 r = (f32x4){__uint_as_float(v.x << 16), __uint_as_float(v.x & 0xffff0000u), __uint_as_float(v.y << 16), __uint_as_float(v.y & 0xffff0000u)};
                        const f32x4 x = r + gv[bj][n] * acc[ai][bj][m][n]; acc[ai][bj][m][n] = x; ss += (x[0] * x[0] + x[1] * x[1]) + (x[2] * x[2] + x[3] * x[3]); }
                ss += __shfl_xor(ss, 16); ss += __shfl_xor(ss, 32);
                if (fq == 0) rowss[(size_t)row * 16 + u.pn * 4 + wc] = ss;
                asm volatile("" ::: "memory");
            }
        }
        asm volatile("s_waitcnt vmcnt(0)" ::: "memory"); __builtin_amdgcn_s_barrier(); asm volatile("" ::: "memory");
        if (wid == 0 && lane == 0) {
            __builtin_amdgcn_fence(__ATOMIC_RELEASE, "agent"); asm volatile("s_waitcnt vmcnt(0)" ::: "memory");
            __hip_atomic_fetch_add(pcnt, 1u, __ATOMIC_RELAXED, __HIP_MEMORY_SCOPE_AGENT);
            unsigned sp = 0; while (__hip_atomic_load(pcnt, __ATOMIC_RELAXED, __HIP_MEMORY_SCOPE_AGENT) < 4u) { __builtin_amdgcn_s_sleep(1); if (++sp > (1u << 22)) break; }
            __builtin_amdgcn_fence(__ATOMIC_ACQUIRE, "agent"); asm volatile("s_waitcnt vmcnt(0)" ::: "memory"); }
        __builtin_amdgcn_s_barrier(); asm volatile("" ::: "memory");
        const LAS float* rtab = rstd_table(rowss, u.pm, ldsx, wid, lane);
        f32x4 fgv[2][2];
#pragma unroll
        for (int bj = 0; bj < 2; ++bj)
#pragma unroll
            for (int n = 0; n < 2; ++n) fgv[bj][n] = *(const f32x4*)(fg + col0 + bj * 128 + n * 16);
#pragma unroll
        for (int ai = 0; ai < 2; ++ai)
#pragma unroll
            for (int m = 0; m < 4; ++m) { const int rl_ = ai * 128 + wr * 64 + m * 16 + fr; const float rs = rtab[rl_]; const size_t off = (size_t)(u.pm * 256 + rl_) * D + col0;
#pragma unroll
                for (int bj = 0; bj < 2; ++bj)
#pragma unroll
                    for (int n = 0; n < 2; ++n) { const f32x4 y = acc[ai][bj][m][n] * rs * fgv[bj][n]; st16_wt(out + off + bj * 128 + n * 16, __builtin_bit_cast(u32x4, y)); } }
    }
};

struct EpiGU {
    static constexpr bool PERM = true, MIDK = false, PRE = true;
    unsigned char* ws; int l;
    typedef RstdAhead PreRegs;
    __device__ __forceinline__ void pre_issue(PreRegs& r, int pm, int wid, int lane) const { rstd_issue(r, (const float*)(ws + WS_ROWSS), pm, wid * 64 + lane); }
    __device__ __forceinline__ void pre_commit(const PreRegs& r, LAS unsigned char* ldsx, int wid, int lane) const { rstd_commit(r, (LAS float*)(ldsx + 4096), wid * 64 + lane); }
    static __device__ __forceinline__ float dpp_shr1(float old, float v) { return __int_as_float(__builtin_amdgcn_update_dpp(__float_as_int(old), __float_as_int(v), 0x111, 0xf, 0xf, false)); }
    static __device__ __forceinline__ float dpp_shr2(float old, float v) { return __int_as_float(__builtin_amdgcn_update_dpp(__float_as_int(old), __float_as_int(v), 0x112, 0xf, 0xf, false)); }
    static __device__ __forceinline__ float dpp_ror1(float v) { return __int_as_float(__builtin_amdgcn_update_dpp(0, __float_as_int(v), 0x121, 0xf, 0xf, true)); }
    static __device__ __forceinline__ float dpp_ror2(float v) { return __int_as_float(__builtin_amdgcn_update_dpp(0, __float_as_int(v), 0x122, 0xf, 0xf, true)); }
    __device__ __forceinline__ void operator()(f32x4 (&acc)[2][2][4][2], const pg8::Unit& u, int wr, int wc, int fr, int fq, LAS unsigned char* ldsx, int wid, int lane, int par, int nxt_pm) const {
        asm volatile("" : "+v"(fr), "+v"(fq), "+v"(lane)); asm volatile("" : "+s"(wr), "+s"(wc));
        RstdAhead ra; if (nxt_pm >= 0) rstd_issue(ra, (const float*)(ws + WS_ROWSS), nxt_pm, wid * 64 + lane);
        const float* shw = (const float*)(ws + WS_SHWG) + (size_t)l * NB * NGU; const float* cw = (const float*)(ws + WS_FCW) + (size_t)l * 4 * FF; const float* cb = cw + 3 * FF;
        bf16_t* ACT = (bf16_t*)(ws + WS_ACT); float* gfirst = (float*)(ws + WS_GFIRST); float* glast = (float*)(ws + WS_GLAST); float* ufirst = (float*)(ws + WS_UFIRST);
        const int b = u.pm >> 3, cin = wc * 32 + 8 * fq, colg = u.pn * 128 + cin;
        f32x4 bgv[2], buv[2], w0v[2], w1v[2], w2v[2], cbvv[2];
#pragma unroll
        for (int n = 0; n < 2; ++n) { bgv[n] = *(const f32x4*)(shw + (size_t)b * NGU + u.pn * 256 + cin + 4 * n); buv[n] = *(const f32x4*)(shw + (size_t)b * NGU + u.pn * 256 + 128 + cin + 4 * n);
            w0v[n] = *(const f32x4*)(cw + colg + 4 * n); w1v[n] = *(const f32x4*)(cw + FF + colg + 4 * n); w2v[n] = *(const f32x4*)(cw + 2 * FF + colg + 4 * n); cbvv[n] = *(const f32x4*)(cb + colg + 4 * n); }
        const LAS float* rtab = (const LAS float*)(ldsx + 4096 + 1024 * par);
        LAS float* halo = (LAS float*)ldsx;
#pragma unroll
        for (int ai = 0; ai < 2; ++ai)
#pragma unroll
            for (int m = 0; m < 4; ++m) { const float rs = rtab[ai * 128 + wr * 64 + m * 16 + fr];
#pragma unroll
                for (int n = 0; n < 2; ++n) { acc[ai][0][m][n] = acc[ai][0][m][n] * rs + bgv[n]; acc[ai][1][m][n] = acc[ai][1][m][n] * rs + buv[n]; }
                if (m == 3) { if (fr >= 14) {
#pragma unroll
                    for (int n = 0; n < 2; ++n) *(LAS f32x4*)(halo + ((ai * 2 + wr) * 2 + (fr - 14)) * 128 + cin + 4 * n) = acc[ai][0][3][n]; } } }
        LDS_WAIT(); __builtin_amdgcn_s_barrier(); asm volatile("" ::: "memory");
        const bool f0 = fr == 0, f01 = fr < 2;
#pragma unroll
        for (int ai = 0; ai < 2; ++ai)
#pragma unroll
            for (int m = 0; m < 4; ++m) {
                const size_t row = (size_t)u.pm * 256 + ai * 128 + wr * 64 + m * 16 + fr;
                u32x4 wout;
#pragma unroll
                for (int n = 0; n < 2; ++n) {
                    const f32x4 w0 = w0v[n], w1 = w1v[n], w2 = w2v[n], cbv = cbvv[n];
                    const f32x4 g0 = acc[ai][0][m][n]; f32x4 g1, g2;
                    if (m > 0) { const f32x4 P = acc[ai][0][m > 0 ? m - 1 : 0][n];
#pragma unroll
                        for (int j = 0; j < 4; ++j) { g1[j] = dpp_shr1(dpp_ror1(P[j]), g0[j]); g2[j] = dpp_shr2(dpp_ror2(P[j]), g0[j]); } }
                    else { const int slot = wr == 1 ? ai * 2 : (ai == 1 ? 1 : 0);
                        const f32x4 p14 = *(const LAS f32x4*)(halo + (slot * 2 + 0) * 128 + cin + 4 * n), p15 = *(const LAS f32x4*)(halo + (slot * 2 + 1) * 128 + cin + 4 * n);
#pragma unroll
                        for (int j = 0; j < 4; ++j) { g1[j] = dpp_shr1(p15[j], g0[j]); g2[j] = dpp_shr2(f0 ? p14[j] : p15[j], g0[j]); } }
                    const f32x4 cv = cbv + w0 * g2 + w1 * g1 + w2 * g0, up = acc[ai][1][m][n];
                    if (ai == 0 && m == 0) { if (wr == 0 && f01) { *(f32x4*)(gfirst + ((size_t)u.pm * 2 + fr) * FF + colg + 4 * n) = g0; *(f32x4*)(ufirst + ((size_t)u.pm * 2 + fr) * FF + colg + 4 * n) = up; } }
                    if (ai == 1 && m == 3) { if (wr == 1 && fr >= 14) *(f32x4*)(glast + ((size_t)u.pm * 2 + (fr - 14)) * FF + colg + 4 * n) = g0; }
                    const float r0 = siluf_(cv[0]) * up[0], r1 = siluf_(cv[1]) * up[1], r2 = siluf_(cv[2]) * up[2], r3 = siluf_(cv[3]) * up[3];
                    if (n == 0) { wout.x = cvt_pk_bf16(r0, r1); wout.y = cvt_pk_bf16(r2, r3); } else { wout.z = cvt_pk_bf16(r0, r1); wout.w = cvt_pk_bf16(r2, r3); }
                }
                if (ai == 0 && m == 0) { if (!(wr == 0 && f01)) st16_wt(ACT + row * FF + colg, wout); }
                else st16_wt(ACT + row * FF + colg, wout);
            }
        if (nxt_pm >= 0) rstd_commit(ra, (LAS float*)(ldsx + 4096 + 1024 * (par ^ 1)), wid * 64 + lane);
    }
};

#define XB_TMO      128
#define XB_XCNT(j)  (256  + 64 * (j))
#define XB_XSUB(j)  (1280 + 64 * (j))
#define XB_XGEN(j)  (2304 + 64 * (j))
#define XB_TOP      3328
#define XB_TOPGEN   3392
#define XCD_BAR_WORDS 3456
#define XB_SPIN_CAP (1u << 18)
__device__ __forceinline__ unsigned xb_ld(unsigned* p)              { return __hip_atomic_load(p, __ATOMIC_RELAXED, __HIP_MEMORY_SCOPE_AGENT); }
__device__ __forceinline__ unsigned xb_add(unsigned* p, unsigned v) { return __hip_atomic_fetch_add(p, v, __ATOMIC_RELAXED, __HIP_MEMORY_SCOPE_AGENT); }
__device__ __forceinline__ unsigned xb_xcc_id() { return (unsigned)__builtin_amdgcn_s_getreg((3 << 11) | 20) & 0xFu; }
#define XB_SPIN(cond, bar) do { unsigned _sp = 0; while (cond) { __builtin_amdgcn_s_sleep(1); \
    if ((++_sp & 255u) == 0u) { if (xb_ld(&(bar)[XB_TMO])) break; if (_sp > XB_SPIN_CAP) { atomicAdd(&(bar)[XB_TMO], 1u); break; } } } } while (0)
__device__ __forceinline__ void xcd_barrier_complete(unsigned* bar, unsigned x, unsigned& nloc, unsigned& nx) {
    const unsigned G = gridDim.x * gridDim.y * gridDim.z;
    unsigned sum, cnt, mine, sp = 0u;
    for (;;) {
        sum = 0u; cnt = 0u; mine = 0u;
#pragma unroll
        for (unsigned j = 0; j < 16; ++j) { const unsigned c = xb_ld(&bar[XB_XCNT(j)]); sum += c; cnt += (c > 0u) ? 1u : 0u; mine = (j == x) ? c : mine; }
        if (sum == G) break;
        __builtin_amdgcn_s_sleep(1);
        if ((++sp & 255u) == 0u) { if (xb_ld(&bar[XB_TMO])) break; if (sp > XB_SPIN_CAP) { atomicAdd(&bar[XB_TMO], 1u); break; } }
    }
    nloc = mine > 0u ? mine : 1u; nx = cnt > 0u ? cnt : 1u;
}
__device__ __forceinline__ void xcd_barrier(unsigned* bar, volatile LAS unsigned* st) {
    asm volatile("s_waitcnt vmcnt(0)" ::: "memory");
    __syncthreads();
    if (threadIdx.x == 0) {
        __builtin_amdgcn_s_waitcnt(0);
        const unsigned x = xb_xcc_id();
        unsigned nloc = st[0], nx = st[1];
        if (nloc == 0u) { xcd_barrier_complete(bar, x, nloc, nx); st[0] = nloc; st[1] = nx; }
        const unsigned old = xb_add(&bar[XB_XSUB(x)], 1u);
        const unsigned gen = old / nloc;
        if (old + 1u == (gen + 1u) * nloc) {
            __builtin_amdgcn_fence(__ATOMIC_RELEASE, "agent");
            asm volatile("s_waitcnt vmcnt(0)" ::: "memory");
            const unsigned og = xb_add(&bar[XB_TOP], 1u);
            const unsigned tg = og / nx;
            if (og + 1u == (tg + 1u) * nx) xb_add(&bar[XB_TOPGEN], 1u);
            else XB_SPIN(xb_ld(&bar[XB_TOPGEN]) == tg, bar);
            __builtin_amdgcn_fence(__ATOMIC_ACQUIRE, "agent");
            xb_add(&bar[XB_XGEN(x)], 1u);
            asm volatile("s_waitcnt vmcnt(0)" ::: "memory");
        } else {
            XB_SPIN(xb_ld(&bar[XB_XGEN(x)]) == gen, bar);
            __builtin_amdgcn_fence(__ATOMIC_ACQUIRE, "agent");
            asm volatile("s_waitcnt vmcnt(0)" ::: "memory");
        }
    }
    __syncthreads();
}

struct Args { const float* in[29]; float* out; unsigned char* ws; int ph_lo, ph_hi; };
struct Frame {
    LAS unsigned char* lds; int tid, lane, wave, G, bid;
    volatile LAS unsigned long long* inl; float* out; unsigned char* ws;
};
__device__ __forceinline__ const float* INP(const Frame& F, int k) { const unsigned long long v = F.inl[k]; const unsigned lo = __builtin_amdgcn_readfirstlane((unsigned)v), hi = __builtin_amdgcn_readfirstlane((unsigned)(v >> 32)); return (const float*)(((unsigned long long)hi << 32) | lo); }
#define IN_X 0
#define IN_C 1
#define IN_ADAW 2
#define IN_ADAB 3
#define IN_MIXG 4
#define IN_FFNG 5
#define IN_WIN 6
#define IN_GATEB 7
#define IN_CPOS 8
#define IN_CW1 9
#define IN_CB1 10
#define IN_CW2 11
#define IN_CB2 12
#define IN_LCW 13
#define IN_LCB 14
#define IN_LWA 15
#define IN_LBA 16
#define IN_LWX 17
#define IN_LBX 18
#define IN_LLAM 19
#define IN_NSAG 20
#define IN_LRUG 21
#define IN_WOUT 22
#define IN_WG 23
#define IN_WU 24
#define IN_FCW 25
#define IN_FCB 26
#define IN_WD 27
#define IN_FING 28

__device__ __forceinline__ void ph_mod(const Frame& F) {
    LAS float* cact = (LAS float*)F.lds;
    LAS float* part = cact + 8192;
    const float* c = INP(F, IN_C);
    for (int i = F.tid; i < NB * D; i += 512) { const float v = c[i]; cact[i] = siluf_(v); }
    __syncthreads();
    float* mod = (float*)(F.ws + WS_MOD);
    for (int item = F.bid; item < NL * 192; item += F.G) {
        const int l = item / 192, n0 = (item % 192) * 32, col = F.lane & 31, kp = F.lane >> 5;
        const float* w = INP(F, IN_ADAW) + (size_t)l * D * 6144 + n0 + col;
        float acc[8];
#pragma unroll
        for (int b = 0; b < 8; ++b) acc[b] = 0.f;
#pragma unroll 32
        for (int i = 0; i < 64; ++i) { const int k = F.wave * 128 + 2 * i + kp; const float wv = __builtin_nontemporal_load(w + (size_t)k * 6144);
#pragma unroll
            for (int b = 0; b < 8; ++b) acc[b] += cact[b * D + k] * wv; }
#pragma unroll
        for (int b = 0; b < 8; ++b) acc[b] += __shfl_xor(acc[b], 32);
        if (F.lane < 32) {
#pragma unroll
            for (int b = 0; b < 8; ++b) part[(F.wave * 8 + b) * 32 + col] = acc[b]; }
        __syncthreads();
        if (F.tid < 256) { const int b = F.tid >> 5, cc = F.tid & 31; float s = 0.f;
#pragma unroll
            for (int w8 = 0; w8 < 8; ++w8) s += part[(w8 * 8 + b) * 32 + cc];
            mod[(size_t)(l * NB + b) * 6144 + n0 + cc] = s + INP(F, IN_ADAB)[l * 6144 + n0 + cc]; }
        __syncthreads();
    }
}
template <class SRC> __device__ __forceinline__ void tr_tile(const SRC& src, int K, bf16_t* dst, int k0, int n0, LAS float* scr, int lane) {
    float tv[32];
#pragma unroll
    for (int i = 0; i < 32; ++i) tv[i] = src(k0 + 2 * i + (lane >> 5), n0 + (lane & 31));
#pragma unroll
    for (int i = 0; i < 32; ++i) scr[(2 * i + (lane >> 5)) * 33 + (lane & 31)] = tv[i];
    LDS_WAIT(); asm volatile("" ::: "memory");
    const int c = lane & 7;
#pragma unroll
    for (int j = 0; j < 4; ++j) { const int n = (lane >> 3) + 8 * j; const LAS float* s = scr + (8 * c) * 33 + n;
        u32x4 o; o.x = cvt_pk_bf16(s[0 * 33], s[1 * 33]); o.y = cvt_pk_bf16(s[2 * 33], s[3 * 33]); o.z = cvt_pk_bf16(s[4 * 33], s[5 * 33]); o.w = cvt_pk_bf16(s[6 * 33], s[7 * 33]);
        *(u32x4*)(dst + (size_t)(n0 + n) * K + k0 + 8 * c) = o; }
    LDS_WAIT(); asm volatile("" ::: "memory");
}
__device__ __forceinline__ void ph_posp(const Frame& F) {
    LAS float* red = (LAS float*)F.lds;
    for (int vb = F.bid; vb < NL * 2 * 32; vb += F.G) { const int lk = vb >> 5, sl = vb & 31, n = F.tid & 255, kh = F.tid >> 8;
        const float* W = INP(F, IN_CW1) + (size_t)lk * 2048 * 256 + (size_t)(sl * 64 + kh * 32) * 256 + n; const float* pos = INP(F, IN_CPOS) + (size_t)lk * 2048 + sl * 64 + kh * 32;
        float sacc = 0.f;
#pragma unroll
        for (int k = 0; k < 32; ++k) sacc += pos[k] * W[(size_t)k * 256];
        __syncthreads();
        if (kh) red[n] = sacc;
        __syncthreads();
        if (!kh) ((float*)(F.ws + WS_POSP))[((size_t)lk * 32 + sl) * 256 + n] = sacc + red[n]; }
}
__device__ __forceinline__ void ph_convert(const Frame& F) {
    LAS float* scr = (LAS float*)(F.lds + 40960 + F.wave * 8704);
    const int gw = F.bid * 8 + F.wave, NGW = F.G * 8;
    constexpr int I_WIN = 16 * 80, I_WOUT = 16 * 32, I_WGU = 16 * 176, I_WDN = 44 * 32, I_CW1 = 2 * 32 * 8, I_CW2 = 2 * 4 * 2, I_LRU = 8 * 4, I_L = I_WIN + I_WOUT + I_WGU + I_WDN + I_CW1 + I_CW2 + I_LRU;
    for (int it = gw; it < NL * I_L; it += NGW) {
        const int l = it / I_L; int r = it % I_L;
        unsigned char* wl = F.ws + WS_WTS + (size_t)l * WTS_LAYER;
        if (r < I_WIN) { const float* W = INP(F, IN_WIN) + (size_t)l * D * NINSRC;
            auto src = [=](int k, int n) -> float { return n < 1280 ? __builtin_nontemporal_load(W + (size_t)k * NINSRC + n) : n < 2304 ? __builtin_nontemporal_load(W + (size_t)k * NINSRC + n + 24) : n < 2328 ? __builtin_nontemporal_load(W + (size_t)k * NINSRC + n - 1024) : 0.f; };
            tr_tile(src, D, (bf16_t*)(wl + WO_WIN), (r / 80) * 64, (r % 80) * 32, scr, F.lane); continue; } r -= I_WIN;
        if (r < I_WOUT) { const float* W = INP(F, IN_WOUT) + (size_t)l * D * D; const float* g1 = INP(F, IN_NSAG) + l * 512; const float* g2 = INP(F, IN_LRUG) + l * 512;
            auto src = [=](int k, int n) -> float { return __builtin_nontemporal_load(W + (size_t)k * D + n) * (k < 512 ? g1[k] : g2[k - 512]); };
            tr_tile(src, D, (bf16_t*)(wl + WO_WOUT), (r / 32) * 64, (r % 32) * 32, scr, F.lane); continue; } r -= I_WOUT;
        if (r < I_WGU) { const float* Wg = INP(F, IN_WG) + (size_t)l * D * FF; const float* Wu = INP(F, IN_WU) + (size_t)l * D * FF;
            auto src = [=](int k, int n) -> float { const int un = n >> 8, w = n & 255; return w < 128 ? __builtin_nontemporal_load(Wg + (size_t)k * FF + un * 128 + w) : __builtin_nontemporal_load(Wu + (size_t)k * FF + un * 128 + w - 128); };
            tr_tile(src, D, (bf16_t*)(wl + WO_WGU), (r / 176) * 64, (r % 176) * 32, scr, F.lane); continue; } r -= I_WGU;
        if (r < I_WDN) { const float* W = INP(F, IN_WD) + (size_t)l * FF * D;
            auto src = [=](int k, int n) -> float { return __builtin_nontemporal_load(W + (size_t)k * D + n); };
            tr_tile(src, FF, (bf16_t*)(wl + WO_WDN), (r / 32) * 64, (r % 32) * 32, scr, F.lane); continue; } r -= I_WDN;
        if (r < I_CW1) { const int kv = r / 256, rr = r % 256, nt = rr >> 5, ksb = (rr & 31) * 4; const float* W = INP(F, IN_CW1) + (size_t)(l * 2 + kv) * 2048 * 256;
            bf16_t* dst = (bf16_t*)(wl + WO_CW1) + (((size_t)(kv * 8 + nt) * 128 + ksb) * 64 + F.lane) * 8;
#pragma unroll
            for (int q = 0; q < 4; ++q) { const int k0 = 16 * (ksb + q) + 8 * (F.lane >> 5), nn = 32 * nt + (F.lane & 31); float v[8];
#pragma unroll
                for (int j = 0; j < 8; ++j) v[j] = W[(size_t)(k0 + j) * 256 + nn];
                u32x4 o; o.x = pk2(v[0], v[1]); o.y = pk2(v[2], v[3]); o.z = pk2(v[4], v[5]); o.w = pk2(v[6], v[7]); *(u32x4*)(dst + (size_t)q * 512) = o; }
            continue; } r -= I_CW1;
        if (r < I_CW2) { const int kv = r / 8, rr = r % 8; const float* W = INP(F, IN_CW2) + (size_t)(l * 2 + kv) * 256 * 64;
            auto src = [=](int k, int n) -> float { return W[(size_t)k * 64 + n]; };
            tr_tile(src, 256, (bf16_t*)(wl + WO_CW2) + (size_t)kv * 64 * 256, (rr / 2) * 64, (rr % 2) * 32, scr, F.lane); continue; } r -= I_CW2;
        { const int blk = r / 4, nb = r % 4; const float* Wa = INP(F, IN_LWA) + (size_t)(l * 8 + blk) * 4096; const float* Wx = INP(F, IN_LWX) + (size_t)(l * 8 + blk) * 4096;
            auto src = [=](int k, int n) -> float { return n < 64 ? Wa[k * 64 + n] : Wx[k * 64 + n - 64]; };
            tr_tile(src, 64, (bf16_t*)(wl + WO_LRUW) + (size_t)blk * 128 * 64, 0, nb * 32, scr, F.lane); }
    }
}

__device__ __forceinline__ void ph_prep(const Frame& F) {
    const float* mod = (const float*)(F.ws + WS_MOD);
    for (int vb = F.bid; vb < 256; vb += F.G) {
        const int l = vb >> 6, sub = vb & 63; const bool isg = sub >= 20; const int rbase = (isg ? sub - 20 : sub) * 128;
        constexpr int SHS = 2112;
        LAS unsigned char* shl = F.lds;
        __syncthreads();
        for (int i = F.tid; i < NB * D / 2; i += 512) { const int b = i >> 9, k = (i & 511) * 2;
            const f32x2 v = *(const f32x2*)(mod + (size_t)(l * NB + b) * 6144 + (isg ? 3072 : 0) + k);
            const unsigned h0 = f2bf(v.x), h1 = f2bf(v.y);
            *(LAS unsigned*)(shl + b * SHS + k * 2) = h0 | (h1 << 16);
            *(LAS unsigned*)(shl + (8 + b) * SHS + k * 2) = pk2(v.x - bf2f(h0), v.y - bf2f(h1)); }
        __syncthreads();
        const bf16_t* Wt = (const bf16_t*)(F.ws + WS_WTS + (size_t)l * WTS_LAYER + (isg ? WO_WGU : WO_WIN));
        float* dst = (float*)(F.ws + (isg ? WS_SHWG : WS_SHW1)) + (size_t)l * NB * (isg ? NGU : NIN); const int ldn = isg ? NGU : NIN;
        const int n0 = rbase + F.wave * 16, fr = F.lane & 15, fq = F.lane >> 4;
        const bf16_t* wp = Wt + (size_t)(n0 + fr) * D + 8 * fq;
        const LAS unsigned char* bp = shl + (fr & 7) * SHS + 16 * fq;
        f32x4 acc = {0.f, 0.f, 0.f, 0.f};
#pragma unroll
        for (int h = 0; h < 2; ++h) {
            bf16x8 af[16];
#pragma unroll
            for (int q = 0; q < 16; ++q) af[q] = *(const bf16x8*)(wp + (h * 16 + q) * 32);
#pragma unroll
            for (int q = 0; q < 16; ++q) { const int ko = (h * 16 + q) * 64;
                const bf16x8 bh = *(const LAS bf16x8*)(bp + ko), bl = *(const LAS bf16x8*)(bp + 8 * SHS + ko);
                acc = __builtin_amdgcn_mfma_f32_16x16x32_bf16(af[q], bh, acc, 0, 0, 0); acc = __builtin_amdgcn_mfma_f32_16x16x32_bf16(af[q], bl, acc, 0, 0, 0); }
        }
        if (fr < 8) *(f32x4*)(dst + (size_t)fr * ldn + n0 + 4 * fq) = acc;
    }
    __syncthreads();
    {   float* posb = (float*)(F.ws + WS_POSB); const float* posp = (const float*)(F.ws + WS_POSP);
        for (int i = F.bid * 512 + F.tid; i < NL * 2 * 256; i += F.G * 512) { const int n = i & 255, lk = i >> 8; float sacc = INP(F, IN_CB1)[lk * 256 + n];
#pragma unroll
            for (int sl = 0; sl < 32; ++sl) sacc += posp[((size_t)lk * 32 + sl) * 256 + n];
            posb[i] = sacc; }
    }
    {   float* fcw = (float*)(F.ws + WS_FCW);
        for (int i = F.bid * 512 + F.tid; i < NL * 4 * FF; i += F.G * 512) { const int col = i % FF, k = (i / FF) & 3, l = i / (4 * FF); fcw[i] = k < 3 ? INP(F, IN_FCW)[(size_t)(l * 3 + k) * FF + col] : INP(F, IN_FCB)[(size_t)l * FF + col]; }
    }
    {
        float* gs = (float*)(F.ws + WS_GS);
        for (int i = F.bid * 512 + F.tid; i < NL * 2 * NB * D; i += F.G * 512) { const int col = i & 1023, b = (i >> 10) & 7, w = (i >> 13) & 1, l = i >> 14;
            gs[i] = INP(F, w ? IN_FFNG : IN_MIXG)[l * D + col] * (1.0f + mod[(size_t)(l * NB + b) * 6144 + (w ? 4096 : 1024) + col]); }
    }
    {
        const float* x = INP(F, IN_X); bf16_t* XG = (bf16_t*)(F.ws + WS_XG); float* rowss = (float*)(F.ws + WS_ROWSS); const float* mg = INP(F, IN_MIXG);
        for (int rw = (F.bid * 8 + F.wave) * 8; rw < T; rw += F.G * 64) { const int b = rw >> 11; f32x4 gm[4], v[4];
#pragma unroll
            for (int j = 0; j < 4; ++j) { const int col = j * 256 + F.lane * 4; v[j] = __builtin_nontemporal_load((const f32x4*)(x + (size_t)rw * D + col));
                gm[j] = *(const f32x4*)(mg + col) * (*(const f32x4*)(mod + (size_t)b * 6144 + 1024 + col) + 1.0f); }
#pragma unroll 1
            for (int i = 0; i < 8; ++i) { const int row = rw + i, rn = i < 7 ? row + 1 : row; f32x4 nv[4]; float ss = 0.f;
#pragma unroll
                for (int j = 0; j < 4; ++j) nv[j] = __builtin_nontemporal_load((const f32x4*)(x + (size_t)rn * D + j * 256 + F.lane * 4));
#pragma unroll
                for (int j = 0; j < 4; ++j) { const int col = j * 256 + F.lane * 4; ss += (v[j][0] * v[j][0] + v[j][1] * v[j][1]) + (v[j][2] * v[j][2] + v[j][3] * v[j][3]);
                    const f32x4 y = v[j] * gm[j]; u32x2 w; w.x = pk2(y[0], y[1]); w.y = pk2(y[2], y[3]); *(u32x2*)(XG + (size_t)row * D + col) = w; }
                ss = wave_sum(ss);
                if (F.lane < 16) rowss[(size_t)row * 16 + F.lane] = F.lane == 0 ? ss : 0.f;
#pragma unroll
                for (int j = 0; j < 4; ++j) v[j] = nv[j]; } }
    }
}

namespace at {
typedef float f32x16 __attribute__((ext_vector_type(16)));
typedef short v4i16_t __attribute__((ext_vector_type(4)));
constexpr int BUF = 16384;
__device__ __forceinline__ int crow(int r, int hi) { return (r & 3) + 8 * (r >> 2) + 4 * hi; }
struct Stg { u32x4 k, v; };
__device__ __forceinline__ void stage_load(Stg& s, const bf16_t* Kg, const bf16_t* Vg, int key0, int wid, int lane) {
    s.k = *(const u32x4*)(Kg + (size_t)(key0 + lane) * 64 + wid * 8);
    s.v = *(const u32x4*)(Vg + (size_t)(key0 + 16 * (wid & 3) + (lane >> 2)) * 64 + (wid >> 2) * 32 + (lane & 3) * 8);
}
__device__ __forceinline__ void stage_write(const Stg& s, LAS unsigned char* buf, int wid, int lane) {
    *(LAS u32x4*)(buf + wid * 1024 + lane * 16) = s.k;
    *(LAS u32x4*)(buf + 8192 + wid * 1024 + lane * 16) = s.v;
}
__device__ __forceinline__ void qkt(f32x16& p0, f32x16& p1, const LAS unsigned char* buf, const bf16x8 (&qr)[4], int r32, int hi) {
    const LAS unsigned char* kb = buf + hi * 1024 + r32 * 16;
    bf16x8 b0[4], b1[4];
#pragma unroll
    for (int d0 = 0; d0 < 4; ++d0) { b0[d0] = *(const LAS bf16x8*)(kb + d0 * 2048); b1[d0] = *(const LAS bf16x8*)(kb + d0 * 2048 + 512); }
    asm volatile("s_waitcnt lgkmcnt(0)" ::: "memory"); __builtin_amdgcn_sched_barrier(0);
#pragma unroll
    for (int d0 = 0; d0 < 4; ++d0) { p0 = __builtin_amdgcn_mfma_f32_32x32x16_bf16(b0[d0], qr[d0], p0, 0, 0, 0); p1 = __builtin_amdgcn_mfma_f32_32x32x16_bf16(b1[d0], qr[d0], p1, 0, 0, 0); }
}
__device__ __forceinline__ bf16x8 vfrag(const LAS unsigned char* p) {
    const v4i16_t lo = __builtin_amdgcn_ds_read_tr16_b64_v4i16((LAS v4i16_t*)p), hi = __builtin_amdgcn_ds_read_tr16_b64_v4i16((LAS v4i16_t*)(p + 512));
    return (bf16x8){lo[0], lo[1], lo[2], lo[3], hi[0], hi[1], hi[2], hi[3]};
}
__device__ __forceinline__ bf16x8 pack8(const f32x16& p, int base) {
    u32x4 w; w.x = cvt_pk_bf16(p[base], p[base + 1]); w.y = cvt_pk_bf16(p[base + 2], p[base + 3]); w.z = cvt_pk_bf16(p[base + 4], p[base + 5]); w.w = cvt_pk_bf16(p[base + 6], p[base + 7]);
    return __builtin_bit_cast(bf16x8, w);
}
__device__ __forceinline__ void pv(f32x16 (&o)[2], const LAS unsigned char* buf, const f32x16& p0, const f32x16& p1, int lane, int hi) {
    const LAS unsigned char* vb = buf + 8192 + ((lane >> 4) & 1) * 32 + (lane & 3) * 8 + (4 * hi + ((lane & 15) >> 2)) * 64;
    const bf16x8 P0 = pack8(p0, 0), P1 = pack8(p0, 8), P2 = pack8(p1, 0), P3 = pack8(p1, 8);
    bf16x8 vf[2][4];
#pragma unroll
    for (int d0 = 0; d0 < 2; ++d0)
#pragma unroll
        for (int k4 = 0; k4 < 4; ++k4) vf[d0][k4] = vfrag(vb + d0 * 4096 + k4 * 1024);
    asm volatile("s_waitcnt lgkmcnt(0)" ::: "memory"); __builtin_amdgcn_sched_barrier(0);
#pragma unroll
    for (int d0 = 0; d0 < 2; ++d0) {
        o[d0] = __builtin_amdgcn_mfma_f32_32x32x16_bf16(vf[d0][0], P0, o[d0], 0, 0, 0);
        o[d0] = __builtin_amdgcn_mfma_f32_32x32x16_bf16(vf[d0][1], P1, o[d0], 0, 0, 0);
        o[d0] = __builtin_amdgcn_mfma_f32_32x32x16_bf16(vf[d0][2], P2, o[d0], 0, 0, 0);
        o[d0] = __builtin_amdgcn_mfma_f32_32x32x16_bf16(vf[d0][3], P3, o[d0], 0, 0, 0); }
}
__device__ __forceinline__ float xhalf(float v) { return __shfl_xor(v, 32); }
__device__ __forceinline__ float max3f(float a, float b, float c) { float r; asm("v_max3_f32 %0, %1, %2, %3" : "=v"(r) : "v"(a), "v"(b), "v"(c)); return r; }
__device__ __forceinline__ float rowmax32(f32x16& p0, f32x16& p1) {
    asm volatile("s_nop 15\n\ts_nop 7" : "+v"(p0), "+v"(p1));
    float a = max3f(p0[0], p0[1], p1[0]), b = max3f(p0[2], p0[3], p1[1]); a = max3f(a, p1[2], p1[3]);
#pragma unroll
    for (int r = 4; r < 16; r += 4) { a = max3f(a, p0[r], p0[r + 1]); b = max3f(b, p0[r + 2], p0[r + 3]); a = max3f(a, p1[r], p1[r + 1]); b = max3f(b, p1[r + 2], p1[r + 3]); }
    a = max3f(a, b, b);
    return max3f(a, xhalf(a), a);
}
constexpr float MASKED = -1.0e6f;
__device__ __forceinline__ void softmax_step(f32x16& p0, f32x16& p1, float& m, float& l, f32x16 (&o)[2], f32x16& negm) {
    const float rm = rowmax32(p0, p1);
    if (__any(rm > 0.f)) { const float dl = fmaxf(rm, 0.f), f = __builtin_amdgcn_exp2f(-dl); m += dl; l *= f;
#pragma unroll
        for (int r = 0; r < 16; ++r) { p0[r] -= dl; p1[r] -= dl; o[0][r] *= f; o[1][r] *= f; negm[r] = -m; } }
    float s = 0.f;
#pragma unroll
    for (int r = 0; r < 16; ++r) { p0[r] = __builtin_amdgcn_exp2f(p0[r]); p1[r] = __builtin_amdgcn_exp2f(p1[r]); s += p0[r] + p1[r]; }
    l += s;
}
constexpr float NEGBIG = -3.0e38f;
__device__ __forceinline__ void unit(const Frame& F, int l, int bg, int qb, unsigned* cmpdone) {
    int lane_ = F.lane; asm volatile("" : "+v"(lane_));
    const int wid = F.wave, lane = lane_, r32 = lane & 31, hi = lane >> 5, b = bg >> 1, g = bg & 1, rh = wid >> 1, hd = g * 4 + rh, tq = (wid & 1) * 32 + r32, t = qb * 64 + tq;
    LAS unsigned char* lds = F.lds;
    const size_t kvo = (size_t)bg * SEQ * 64;
    bf16x8 qr[4];
    {   const bf16_t* Q = (const bf16_t*)(F.ws + WS_Q) + ((size_t)b * SEQ + t) * 512 + hd * 64;
#pragma unroll
        for (int d0 = 0; d0 < 4; ++d0) qr[d0] = __builtin_nontemporal_load((const bf16x8*)(Q + d0 * 16 + hi * 8)); }
    float gt0, gt1, gt2;
    {   const float* ZG = (const float*)(F.ws + WS_ZG) + ((size_t)b * SEQ + t) * 24 + g * 12 + rh * 3; const float* gb = INP(F, IN_GATEB) + l * 24 + g * 12 + rh * 3;
        gt0 = sigmoidf_(ZG[0] + gb[0]); gt1 = sigmoidf_(ZG[1] + gb[1]); gt2 = sigmoidf_(ZG[2] + gb[2]); }
    f32x16 oacc[2];
    volatile LAS unsigned* rdy = (volatile LAS unsigned*)(F.lds + MISC_OFF + 252);
    __syncthreads();
    if (F.tid == 0) { const unsigned ok = __hip_atomic_load(cmpdone + bg, __ATOMIC_RELAXED, __HIP_MEMORY_SCOPE_AGENT) >= 4u ? 1u : 0u;
        if (ok) { __builtin_amdgcn_fence(__ATOMIC_ACQUIRE, "agent"); asm volatile("s_waitcnt vmcnt(0)" ::: "memory"); }
        *rdy = ok; }
    __syncthreads();
    const bool early = *rdy != 0u;
    const bf16_t* Kc = (const bf16_t*)(F.ws + WS_KCMP) + (size_t)bg * 8192; const bf16_t* Vc = (const bf16_t*)(F.ws + WS_KCMP) + (size_t)(16 + bg) * 8192;
    Stg sc0, sc1;
    if (early) { stage_load(sc0, Kc, Vc, 0, wid, lane); stage_load(sc1, Kc, Vc, 64, wid, lane); }
    {
        f32x16 o[2], negm; float m = 0.f, lsum = 0.f;
#pragma unroll
        for (int r = 0; r < 16; ++r) { o[0][r] = 0.f; o[1][r] = 0.f; negm[r] = 0.f; }
        const bf16_t* Kg = (const bf16_t*)(F.ws + WS_KV + 4 * KV_STRIDE) + kvo; const bf16_t* Vg = (const bf16_t*)(F.ws + WS_KV + 5 * KV_STRIDE) + kvo;
        const int t_lo = qb >= 8 ? qb - 8 : 0, nt = qb - t_lo + 1;
        Stg st; stage_load(st, Kg, Vg, t_lo * 64, wid, lane); stage_write(st, lds, wid, lane);
        __syncthreads();
        for (int i = 0; i < nt; ++i) {
            const int tile = t_lo + i; LAS unsigned char* buf = lds + (i & 1) * BUF;
            if (i + 1 < nt) stage_load(st, Kg, Vg, (tile + 1) * 64, wid, lane);
            f32x16 p0 = negm, p1 = negm;
            qkt(p0, p1, buf, qr, r32, hi);
            if (tile == qb || tile + 8 == qb) {
                const bool cz = tile == qb; const int lim = tq - 4 * hi;
#pragma unroll
                for (int r = 0; r < 16; ++r) { const int c0 = (r & 3) + 8 * (r >> 2), c1 = c0 + 32;
                    const bool v0 = cz ? (c0 <= lim) : (c0 > lim), v1 = cz ? (c1 <= lim) : (c1 > lim);
                    p0[r] = v0 ? p0[r] : MASKED; p1[r] = v1 ? p1[r] : MASKED; } }
            softmax_step(p0, p1, m, lsum, o, negm);
            pv(o, buf, p0, p1, lane, hi);
            if (i + 1 < nt) stage_write(st, lds + ((i + 1) & 1) * BUF, wid, lane);
            __syncthreads();
        }
        lsum += xhalf(lsum);
        const float gate = gt2 / lsum;
#pragma unroll
        for (int r = 0; r < 16; ++r) { oacc[0][r] = o[0][r] * gate; oacc[1][r] = o[1][r] * gate; }
    }
    if (!early) {
        if (F.tid == 0) { unsigned sp = 0;
            while (__hip_atomic_load(cmpdone + bg, __ATOMIC_RELAXED, __HIP_MEMORY_SCOPE_AGENT) < 4u) { __builtin_amdgcn_s_sleep(2); if (++sp > (1u << 22)) break; }
            __builtin_amdgcn_fence(__ATOMIC_ACQUIRE, "agent"); asm volatile("s_waitcnt vmcnt(0)" ::: "memory"); }
        __syncthreads();
        stage_load(sc0, Kc, Vc, 0, wid, lane); stage_load(sc1, Kc, Vc, 64, wid, lane); }
    LAS float* impp = (LAS float*)(lds + 2 * BUF);
    LAS unsigned* selm = (LAS unsigned*)(lds + 2 * BUF + 32768);
    LAS float* ssq = (LAS float*)(lds + 2 * BUF + 32768 + 256);
    {
        stage_write(sc0, lds, wid, lane); stage_write(sc1, lds + BUF, wid, lane);
        __syncthreads();
        f32x16 p[4];
#pragma unroll
        for (int x = 0; x < 4; ++x)
#pragma unroll
            for (int r = 0; r < 16; ++r) p[x][r] = 0.f;
        qkt(p[0], p[1], lds, qr, r32, hi); qkt(p[2], p[3], lds + BUF, qr, r32, hi);
        float mx = -1e30f; const int clim = ((t - 31) >> 4) - 4 * hi;
#pragma unroll
        for (int x = 0; x < 4; ++x)
#pragma unroll
            for (int r = 0; r < 16; ++r) { const int c0 = 32 * x + (r & 3) + 8 * (r >> 2); const bool v = (c0 <= clim) && !(x == 3 && r == 15 && hi == 1); p[x][r] = v ? p[x][r] : NEGBIG; mx = fmaxf(mx, p[x][r]); }
        mx = fmaxf(mx, xhalf(mx)); float sm = 0.f;
#pragma unroll
        for (int x = 0; x < 4; ++x)
#pragma unroll
            for (int r = 0; r < 16; ++r) { p[x][r] = __builtin_amdgcn_exp2f(p[x][r] - mx); sm += p[x][r]; }
        sm += xhalf(sm); const float inv = sm > 0.f ? 1.0f / sm : 0.f;
#pragma unroll
        for (int x = 0; x < 4; ++x)
#pragma unroll
            for (int r = 0; r < 16; ++r) p[x][r] *= inv;
        float eprev = 0.f;
#pragma unroll
        for (int i = 0; i < 16; ++i) { const int x = i >> 2, k = i & 3; const float gsum = (p[x][4 * k] + p[x][4 * k + 1]) + (p[x][4 * k + 2] + p[x][4 * k + 3]), eo = xhalf(p[x][4 * k + 3]);
            impp[(rh * 64 + tq) * 32 + 2 * i + hi] = gsum + (hi ? eo : eprev); eprev = eo; }
        f32x16 oc[2]; oc[0] = (f32x16){}; oc[1] = (f32x16){};
        pv(oc, lds, p[0], p[1], lane, hi); pv(oc, lds + BUF, p[2], p[3], lane, hi);
#pragma unroll
        for (int r = 0; r < 16; ++r) { oacc[0][r] += oc[0][r] * gt0; oacc[1][r] += oc[1][r] * gt0; }
    }
    __syncthreads();
    const bf16_t* Kg = (const bf16_t*)(F.ws + WS_KV + 2 * KV_STRIDE) + kvo; const bf16_t* Vg = (const bf16_t*)(F.ws + WS_KV + 3 * KV_STRIDE) + kvo;
    Stg st; stage_load(st, Kg, Vg, 0, wid, lane); stage_write(st, lds, wid, lane);
    {
        const int qq = 8 * wid + (lane >> 3), sub = lane & 7;
        unsigned smask = qb >= 31 ? 0xffffffffu : ((2u << qb) - 1u);
        if (qb >= 8) {
            float v[4];
#pragma unroll
            for (int e = 0; e < 4; ++e) { const int j = 4 * sub + e; const float sv = (impp[qq * 32 + j] + impp[(64 + qq) * 32 + j]) + (impp[(128 + qq) * 32 + j] + impp[(192 + qq) * 32 + j]); v[e] = (j >= 1 && j <= qb - 2) ? sv : -1e30f; }
            smask = 1u | (3u << (qb - 1));
#pragma unroll 1
            for (int k = 0; k < 5; ++k) { float best = v[0]; int bi = 4 * sub;
#pragma unroll
                for (int e = 1; e < 4; ++e) { const bool gt = v[e] > best; best = gt ? v[e] : best; bi = gt ? 4 * sub + e : bi; }
#pragma unroll
                for (int sft = 0; sft < 3; ++sft) {
                    float ov; int oi;
                    if (sft == 0) { ov = __int_as_float(__builtin_amdgcn_update_dpp(0, __float_as_int(best), 0xB1, 0xf, 0xf, true)); oi = __builtin_amdgcn_update_dpp(0, bi, 0xB1, 0xf, 0xf, true); }
                    else if (sft == 1) { ov = __int_as_float(__builtin_amdgcn_update_dpp(0, __float_as_int(best), 0x4E, 0xf, 0xf, true)); oi = __builtin_amdgcn_update_dpp(0, bi, 0x4E, 0xf, 0xf, true); }
                    else { ov = __int_as_float(__builtin_amdgcn_update_dpp(0, __float_as_int(best), 0x141, 0xf, 0xf, true)); oi = __builtin_amdgcn_update_dpp(0, bi, 0x141, 0xf, 0xf, true); }
                    const bool take = (ov > best) || (ov == best && oi < bi); best = take ? ov : best; bi = take ? oi : bi; }
                smask |= 1u << bi;
#pragma unroll
                for (int e = 0; e < 4; ++e) v[e] = (4 * sub + e == bi) ? -3.4e38f : v[e]; }
        }
        if (sub == 0) selm[qq] = smask;
    }
    __syncthreads();
    const unsigned mask = selm[tq];
    const int nt = qb + 1;
    f32x16 o[2], negm; float m = 0.f, lsum = 0.f;
#pragma unroll
    for (int r = 0; r < 16; ++r) { o[0][r] = 0.f; o[1][r] = 0.f; negm[r] = 0.f; }
    for (int i = 0; i < nt; ++i) {
        LAS unsigned char* buf = lds + (i & 1) * BUF;
        if (i + 1 < nt) stage_load(st, Kg, Vg, (i + 1) * 64, wid, lane);
        const bool selb = (mask >> i) & 1u;
        f32x16 p0;
#pragma unroll
        for (int r = 0; r < 16; ++r) p0[r] = selb ? negm[r] : MASKED;
        f32x16 p1 = p0;
        qkt(p0, p1, buf, qr, r32, hi);
        if (i == qb) { const int lim = tq - 4 * hi;
#pragma unroll
            for (int r = 0; r < 16; ++r) { const int c0 = (r & 3) + 8 * (r >> 2), c1 = c0 + 32; p0[r] = (c0 <= lim) ? p0[r] : MASKED; p1[r] = (c1 <= lim) ? p1[r] : MASKED; } }
        softmax_step(p0, p1, m, lsum, o, negm);
        pv(o, buf, p0, p1, lane, hi);
        if (i + 1 < nt) stage_write(st, lds + ((i + 1) & 1) * BUF, wid, lane);
        __syncthreads();
    }
    lsum += xhalf(lsum);
    const float g1 = gt1 / lsum;
    bf16_t* MX = (bf16_t*)(F.ws + WS_MIXED) + ((size_t)b * SEQ + t) * D + hd * 64;
    float ss = 0.f;
#pragma unroll
    for (int d0 = 0; d0 < 2; ++d0)
#pragma unroll
        for (int i = 0; i < 4; ++i) {
            const float v0 = oacc[d0][4 * i] + g1 * o[d0][4 * i], v1 = oacc[d0][4 * i + 1] + g1 * o[d0][4 * i + 1], v2 = oacc[d0][4 * i + 2] + g1 * o[d0][4 * i + 2], v3 = oacc[d0][4 * i + 3] + g1 * o[d0][4 * i + 3];
            ss += (v0 * v0 + v1 * v1) + (v2 * v2 + v3 * v3);
            u32x2 w; w.x = cvt_pk_bf16(v0, v1); w.y = cvt_pk_bf16(v2, v3); *(u32x2*)(MX + d0 * 32 + 8 * i + 4 * hi) = w; }
    ss += xhalf(ss);
    if (hi == 0) ssq[tq * 4 + rh] = ss;
    __syncthreads();
    if (F.tid < 64) { float* SSN = (float*)(F.ws + WS_SSN); SSN[((size_t)b * SEQ + qb * 64 + F.tid) * 2 + g] = (ssq[F.tid * 4] + ssq[F.tid * 4 + 1]) + (ssq[F.tid * 4 + 2] + ssq[F.tid * 4 + 3]); }
}
}

namespace lr {
typedef float f32x16 __attribute__((ext_vector_type(16)));
constexpr int WREG = 16768;
constexpr int YROW = 80;
__device__ __forceinline__ float xhalf(float v) { return __shfl_xor(v, 32); }
__device__ __forceinline__ void zx_load(u32x4 (&z)[9], const bf16_t* ZXb, int t0, int lane) {
#pragma unroll
    for (int j = 0; j < 9; ++j) { int p = 64 * j + lane; p = p < 67 * 8 ? p : 67 * 8 - 1; const int row = p >> 3, c8 = p & 7, t = t0 - 3 + row; const u32x4 v = *(const u32x4*)(ZXb + (size_t)(t > 0 ? t : 0) * 512 + c8 * 8);
        const unsigned keep = t >= 0 ? 0xffffffffu : 0u; z[j] = (u32x4){v.x & keep, v.y & keep, v.z & keep, v.w & keep}; }
}
__device__ __forceinline__ void zx_park(const u32x4 (&z)[9], LAS unsigned char* ZT, int lane) {
#pragma unroll
    for (int j = 0; j < 9; ++j) { const int p = 64 * j + lane, row = p >> 3, c8 = p & 7; if (p < 67 * 8) *(LAS u32x4*)(ZT + row * 128 + ((c8 ^ (row & 7)) * 16)) = z[j]; }
}
__device__ __forceinline__ void item(const Frame& F, int l, int it) {
    int lane_ = F.lane; asm volatile("" : "+v"(lane_));
    const int b = it >> 4, n = (it >> 1) & 7, hc = it & 1, lane = lane_, w = F.wave, d1 = lane & 31, hi = lane >> 5, ch = 64 * n + 32 * hc + d1;
    LAS unsigned char* XCw = F.lds + w * WREG; LAS unsigned char* ZT = XCw + 8192; LAS unsigned char* YT = XCw;
    LAS float* comp = (LAS float*)(F.lds + 8 * WREG);
    LAS unsigned char* BfL = F.lds + 8 * WREG + 4096;
    LAS float* cwl = (LAS float*)(F.lds + RSTD_OFF);
    const bf16_t* ZXb = (const bf16_t*)(F.ws + WS_ZX) + (size_t)b * SEQ * 512 + 64 * n;
    __syncthreads();
    for (int i = F.tid; i < 320; i += 512) cwl[i] = i < 256 ? INP(F, IN_LCW)[(size_t)(l * 4 + (i >> 6)) * 512 + 64 * n + (i & 63)] : INP(F, IN_LCB)[l * 512 + 64 * n + (i - 256)];
    {   u32x4 z0[9]; zx_load(z0, ZXb, 64 * w, lane); zx_park(z0, ZT, lane); }
    {   const bf16_t* W = (const bf16_t*)(F.ws + WS_WTS + (size_t)l * WTS_LAYER + WO_LRUW) + (size_t)n * 128 * 64; const int gk = F.tid >> 6, gt = gk >> 2, ks = gk & 3;
        *(LAS bf16x8*)(BfL + F.tid * 16) = *(const bf16x8*)(W + (64 * gt + 32 * hc + d1) * 64 + 16 * ks + 8 * hi); }
    const float ba = INP(F, IN_LBA)[l * 512 + ch], bx = INP(F, IN_LBX)[l * 512 + ch], ls8l2 = -8.0f * LOG2E * log1pf(expf(-INP(F, IN_LLAM)[l * 512 + ch]));
    float hcarry = 0.f;
    __syncthreads();
    for (int sw = 0; sw < 4; ++sw) {
        const int t0 = 512 * sw + 64 * w;
        const bf16_t* ZYr = (const bf16_t*)(F.ws + WS_ZY) + ((size_t)b * SEQ + t0) * 512 + 64 * n + 32 * hc;
        u32x4 zyr[4];
#pragma unroll
        for (int j = 0; j < 4; ++j) zyr[j] = __builtin_nontemporal_load((const u32x4*)(ZYr + (size_t)(16 * j + (lane >> 2)) * 512 + (lane & 3) * 8));
#pragma unroll 1
        for (int c8 = 0; c8 < 8; ++c8) {
            float x3[8], x2[8], x1[8], x0[8];
            unpack8(*(const LAS u32x4*)(ZT + (lane + 0) * 128 + ((c8 ^ ((lane + 0) & 7)) * 16)), x3); unpack8(*(const LAS u32x4*)(ZT + (lane + 1) * 128 + ((c8 ^ ((lane + 1) & 7)) * 16)), x2);
            unpack8(*(const LAS u32x4*)(ZT + (lane + 2) * 128 + ((c8 ^ ((lane + 2) & 7)) * 16)), x1); unpack8(*(const LAS u32x4*)(ZT + (lane + 3) * 128 + ((c8 ^ ((lane + 3) & 7)) * 16)), x0);
            float o[8];
#pragma unroll
            for (int j = 0; j < 8; ++j) { const int c = c8 * 8 + j; o[j] = cwl[256 + c] + cwl[c] * x3[j] + cwl[64 + c] * x2[j] + cwl[128 + c] * x1[j] + cwl[192 + c] * x0[j]; }
            u32x4 pk; pk.x = pk2(o[0], o[1]); pk.y = pk2(o[2], o[3]); pk.z = pk2(o[4], o[5]); pk.w = pk2(o[6], o[7]);
            *(LAS u32x4*)(XCw + c8 * 1024 + lane * 16) = pk; }
        f32x16 acc[2][2];
#pragma unroll
        for (int tm = 0; tm < 2; ++tm) { acc[tm][0] = (f32x16){}; acc[tm][1] = (f32x16){}; }
#pragma unroll
        for (int ks = 0; ks < 4; ++ks) { const bf16x8 A0 = *(const LAS bf16x8*)(XCw + (2 * ks + hi) * 1024 + d1 * 16), A1 = *(const LAS bf16x8*)(XCw + (2 * ks + hi) * 1024 + (d1 + 32) * 16);
#pragma unroll
            for (int gt = 0; gt < 2; ++gt) { const bf16x8 Bq = *(const LAS bf16x8*)(BfL + ((gt * 4 + ks) * 64 + lane) * 16);
                acc[0][gt] = __builtin_amdgcn_mfma_f32_32x32x16_bf16(A0, Bq, acc[0][gt], 0, 0, 0); acc[1][gt] = __builtin_amdgcn_mfma_f32_32x32x16_bf16(A1, Bq, acc[1][gt], 0, 0, 0); } }
        float a[2][16], u[2][16]; float Ac = 1.f, Uc = 0.f;
        const int cx = 32 * hc + d1;
#pragma unroll
        for (int tm = 0; tm < 2; ++tm) {
#pragma unroll
            for (int r = 0; r < 16; ++r) { const int tok = 32 * tm + (r & 3) + 8 * (r >> 2) + 4 * hi;
                const float xcv = bf2f(*(const LAS bf16_t*)(XCw + (cx >> 3) * 1024 + tok * 16 + (cx & 7) * 2)), ra = acc[tm][0][r] + ba, ri = acc[tm][1][r] + bx;
                const float rr = __builtin_amdgcn_rcpf(1.0f + __builtin_amdgcn_exp2f(-LOG2E * ra)), ig = __builtin_amdgcn_rcpf(1.0f + __builtin_amdgcn_exp2f(-LOG2E * ri));
                a[tm][r] = __builtin_amdgcn_exp2f(ls8l2 * rr); u[tm][r] = __builtin_amdgcn_sqrtf(fmaxf(1.0f - a[tm][r] * a[tm][r], 0.f)) * (ig * xcv); }
#pragma unroll
            for (int i = 0; i < 4; ++i) {
                const float Ag = (a[tm][4 * i] * a[tm][4 * i + 1]) * (a[tm][4 * i + 2] * a[tm][4 * i + 3]);
                const float Ug = ((u[tm][4 * i] * a[tm][4 * i + 1] + u[tm][4 * i + 1]) * a[tm][4 * i + 2] + u[tm][4 * i + 2]) * a[tm][4 * i + 3] + u[tm][4 * i + 3];
                const float Agp = xhalf(Ag), Ugp = xhalf(Ug);
                const float A1 = hi ? Agp : Ag, U1 = hi ? Ugp : Ug, A2 = hi ? Ag : Agp, U2 = hi ? Ug : Ugp;
                Uc = A2 * (A1 * Uc + U1) + U2; Ac *= A1 * A2; }
        }
        LAS float* cb_ = comp + (sw & 1) * 512;
        if (hi == 0) *(LAS f32x2*)(cb_ + (w * 32 + d1) * 2) = (f32x2){Ac, Uc};
#pragma unroll
        for (int j = 0; j < 4; ++j) *(LAS u32x4*)(YT + (16 * j + (lane >> 2)) * YROW + (lane & 3) * 16) = zyr[j];
        u32x4 zn[9];
        if (sw < 3) zx_load(zn, ZXb, t0 + 512, lane);
        asm volatile("s_waitcnt lgkmcnt(0)" ::: "memory"); __builtin_amdgcn_s_barrier(); asm volatile("" ::: "memory");
        float h = hcarry, hin = 0.f;
#pragma unroll
        for (int w2 = 0; w2 < 8; ++w2) { const f32x2 cu = *(const LAS f32x2*)(cb_ + (w2 * 32 + d1) * 2); if (w2 == w) hin = h; h = cu.x * h + cu.y; }
        hcarry = h;
        h = hin;
#pragma unroll
        for (int tm = 0; tm < 2; ++tm) {
            float zyv[16];
#pragma unroll
            for (int q = 0; q < 16; ++q) zyv[q] = bf2f(*(const LAS bf16_t*)(YT + (32 * tm + 8 * (q >> 2) + 4 * hi + (q & 3)) * YROW + d1 * 2));
#pragma unroll
            for (int q = 0; q < 16; ++q) zyv[q] = gelu_tanh(zyv[q]);
#pragma unroll
            for (int i = 0; i < 4; ++i) {
                const float Ag = (a[tm][4 * i] * a[tm][4 * i + 1]) * (a[tm][4 * i + 2] * a[tm][4 * i + 3]);
                const float Ug = ((u[tm][4 * i] * a[tm][4 * i + 1] + u[tm][4 * i + 1]) * a[tm][4 * i + 2] + u[tm][4 * i + 2]) * a[tm][4 * i + 3] + u[tm][4 * i + 3];
                const float Agp = xhalf(Ag), Ugp = xhalf(Ug);
                const float A1 = hi ? Agp : Ag, U1 = hi ? Ugp : Ug, A2 = hi ? Ag : Agp, U2 = hi ? Ug : Ugp;
                const float hmid = A1 * h + U1; float hh = hi ? hmid : h; h = A2 * hmid + U2;
#pragma unroll
                for (int e = 0; e < 4; ++e) { hh = a[tm][4 * i + e] * hh + u[tm][4 * i + e]; const int tok = 32 * tm + 8 * i + 4 * hi + e;
                    LAS bf16_t* yp = (LAS bf16_t*)(YT + tok * YROW + d1 * 2); *yp = (bf16_t)f2bf(hh * zyv[4 * i + e]); } } }
        bf16_t* MX = (bf16_t*)(F.ws + WS_MIXED) + ((size_t)b * SEQ + t0) * D + 512 + 64 * n + 32 * hc;
#pragma unroll
        for (int j = 0; j < 4; ++j) *(u32x4*)(MX + (size_t)(16 * j + (lane >> 2)) * D + (lane & 3) * 8) = *(const LAS u32x4*)(YT + (16 * j + (lane >> 2)) * YROW + (lane & 3) * 16);
        {   float ss = 0.f;
#pragma unroll
            for (int j = 0; j < 4; ++j) { float v[8]; unpack8(*(const LAS u32x4*)(YT + lane * YROW + j * 16), v);
#pragma unroll
                for (int e = 0; e < 8; ++e) ss += v[e] * v[e]; }
            ((float*)(F.ws + WS_SSL))[((size_t)b * SEQ + t0 + lane) * 16 + 2 * n + hc] = ss; }
        if (sw < 3) zx_park(zn, ZT, lane);
    }
}
}

namespace cp {
typedef float f32x16 __attribute__((ext_vector_type(16)));
__device__ __forceinline__ void item(const Frame& F, int l, int it, unsigned* cmpdone) {
    int lane_ = F.lane; asm volatile("" : "+v"(lane_));
    const int kv = it >> 5, bg = (it >> 1) & 15, c0 = (it & 1) * 64, w = F.wave, lane = lane_, r32 = lane & 31, hi = lane >> 5;
    LAS unsigned char* lds = F.lds;
    const bf16_t* src = (const bf16_t*)(F.ws + WS_KV + (size_t)kv * KV_STRIDE) + (size_t)bg * SEQ * 64 + (size_t)(16 * (c0 + lane)) * 64 + w * 8;
    const bf16_t* W1F = (const bf16_t*)(F.ws + WS_WTS + (size_t)l * WTS_LAYER + WO_CW1) + ((size_t)(kv * 8 + w) * 128 * 64 + lane) * 8;
    __syncthreads();
    f32x16 acc[2]; acc[0] = (f32x16){}; acc[1] = (f32x16){};
    u32x4 sa[4]; bf16x8 Bf[4][4];
#pragma unroll
    for (int s4 = 0; s4 < 4; ++s4) { sa[s4] = *(const u32x4*)(src + (size_t)s4 * 64);
#pragma unroll
        for (int q = 0; q < 4; ++q) Bf[s4][q] = *(const bf16x8*)(W1F + (size_t)(4 * s4 + q) * 512); }
    *(LAS u32x4*)(lds + w * 1024 + lane * 16) = sa[0];
    LDS_WAIT(); __builtin_amdgcn_s_barrier(); asm volatile("" ::: "memory");
#pragma unroll 1
    for (int s4 = 0; s4 < 32; s4 += 4) {
#pragma unroll
        for (int j = 0; j < 4; ++j) { const int sl = s4 + j;
            LAS unsigned char* buf = lds + (sl & 1) * 8192;
#pragma unroll
            for (int q = 0; q < 4; ++q) { const bf16x8 A0 = *(const LAS bf16x8*)(buf + (2 * q + hi) * 1024 + r32 * 16), A1 = *(const LAS bf16x8*)(buf + (2 * q + hi) * 1024 + (r32 + 32) * 16);
                acc[0] = __builtin_amdgcn_mfma_f32_32x32x16_bf16(A0, Bf[j][q], acc[0], 0, 0, 0); acc[1] = __builtin_amdgcn_mfma_f32_32x32x16_bf16(A1, Bf[j][q], acc[1], 0, 0, 0); }
            if (sl + 1 < 32) *(LAS u32x4*)(lds + ((sl + 1) & 1) * 8192 + w * 1024 + lane * 16) = sa[(j + 1) & 3];
            if (sl + 4 < 32) { sa[j] = *(const u32x4*)(src + (size_t)(sl + 4) * 64);
#pragma unroll
                for (int q = 0; q < 4; ++q) Bf[j][q] = *(const bf16x8*)(W1F + (size_t)(4 * (sl + 4) + q) * 512); }
            LDS_WAIT(); __builtin_amdgcn_s_barrier(); asm volatile("" ::: "memory");
        }
    }
    {
        LAS unsigned char* H = lds + 16384; const int nn = 32 * w + r32; const float pb = ((const float*)(F.ws + WS_POSB))[(l * 2 + kv) * 256 + nn];
#pragma unroll
        for (int tm = 0; tm < 2; ++tm)
#pragma unroll
            for (int r = 0; r < 16; ++r) { const int c = 32 * tm + (r & 3) + 8 * (r >> 2) + 4 * hi; *(LAS bf16_t*)(H + (nn >> 3) * 1024 + c * 16 + (nn & 7) * 2) = (bf16_t)f2bf(gelu_tanh(acc[tm][r] + pb)); }
    }
    __syncthreads();
    if (w < 4) {
        const int tm = w & 1, dn = w >> 1, dd = 32 * dn + r32; const LAS unsigned char* H = lds + 16384;
        const bf16_t* W2 = (const bf16_t*)(F.ws + WS_WTS + (size_t)l * WTS_LAYER + WO_CW2) + ((size_t)kv * 64 + dd) * 256;
        f32x16 o = (f32x16){};
#pragma unroll
        for (int ks = 0; ks < 16; ++ks) { const bf16x8 A = *(const LAS bf16x8*)(H + (2 * ks + hi) * 1024 + (32 * tm + r32) * 16), B = *(const bf16x8*)(W2 + 16 * ks + 8 * hi);
            o = __builtin_amdgcn_mfma_f32_32x32x16_bf16(A, B, o, 0, 0, 0); }
        const float b2 = INP(F, IN_CB2)[(size_t)(l * 2 + kv) * 64 + dd];
        bf16_t* dst = (bf16_t*)(F.ws + WS_KCMP) + ((size_t)(kv * 16 + bg) * 128 + c0) * 64 + dd;
#pragma unroll
        for (int r = 0; r < 16; ++r) { const int c = 32 * tm + (r & 3) + 8 * (r >> 2) + 4 * hi; dst[(size_t)c * 64] = (bf16_t)f2bf(c0 + c < 127 ? o[r] + b2 : 0.f); }
    }
    asm volatile("s_waitcnt vmcnt(0)" ::: "memory"); __syncthreads();
    if (F.tid == 0) { __builtin_amdgcn_fence(__ATOMIC_RELEASE, "agent"); asm volatile("s_waitcnt vmcnt(0)" ::: "memory"); __hip_atomic_fetch_add(cmpdone + bg, 1u, __ATOMIC_RELAXED, __HIP_MEMORY_SCOPE_AGENT); }
}
}

__device__ __forceinline__ void fix_rows(const Frame& F, int l, int pm) {
    const float* gf = (const float*)(F.ws + WS_GFIRST); const float* gl = (const float*)(F.ws + WS_GLAST); const float* uf = (const float*)(F.ws + WS_UFIRST);
    const float* cw = (const float*)(F.ws + WS_FCW) + (size_t)l * 4 * FF; bf16_t* ACT = (bf16_t*)(F.ws + WS_ACT);
    for (int col = F.tid; col < FF; col += 512) {
        const float g0 = gf[((size_t)pm * 2) * FF + col], g1 = gf[((size_t)pm * 2 + 1) * FF + col]; float hm2 = 0.f, hm1 = 0.f;
        if (pm & 7) { hm2 = gl[((size_t)(pm - 1) * 2) * FF + col]; hm1 = gl[((size_t)(pm - 1) * 2 + 1) * FF + col]; }
        const float w0 = cw[col], w1 = cw[FF + col], w2 = cw[2 * FF + col], bb = cw[3 * FF + col];
        const float c0 = bb + w0 * hm2 + w1 * hm1 + w2 * g0, c1 = bb + w0 * hm1 + w1 * g0 + w2 * g1;
        ACT[((size_t)pm * 256) * FF + col] = (bf16_t)f2bf(siluf_(c0) * uf[((size_t)pm * 2) * FF + col]);
        ACT[((size_t)pm * 256 + 1) * FF + col] = (bf16_t)f2bf(siluf_(c1) * uf[((size_t)pm * 2 + 1) * FF + col]); }
}
__device__ __forceinline__ void ph_final(const Frame& F) {
    const float* rowss = (const float*)(F.ws + WS_ROWSS); const float* g = INP(F, IN_FING);
    for (int row = F.bid * 8 + F.wave; row < T; row += F.G * 8) {
        float s = F.lane < 16 ? rowss[(size_t)row * 16 + F.lane] : 0.f; s = wave_sum(s); const float rs = rsqrtf(s * (1.0f / D) + EPS);
#pragma unroll
        for (int j = 0; j < 4; ++j) { const int col = j * 256 + F.lane * 4; f32x4 v = *(const f32x4*)(F.out + (size_t)row * D + col); const f32x4 gv = *(const f32x4*)(g + col);
            v = v * rs * gv; *(f32x4*)(F.out + (size_t)row * D + col) = v; } }
}

constexpr int N_PHASES = 2 + 5 * NL;
#ifndef PH_MASK
#define PH_MASK 0xffff
#endif
#define PHON(b) ((PH_MASK >> (b)) & 1)
#ifndef REP_SUB
#define REP_SUB -1
#endif
#define REPS(k) (REP_SUB == (k) ? 2 : 1)
#ifndef FAST_WIN
#define FAST_WIN 1
#endif
#ifndef FAST_SEL
#define FAST_SEL 1
#endif
#define PH_FRAME() Frame F; { size_t z_ = 0; int t_, b_ = blockIdx.x, wv_ = wave0; asm volatile("" : "+s"(z_), "+s"(wv_), "+s"(b_)); \
        asm volatile("v_mbcnt_lo_u32_b32 %0, -1, 0\n\tv_mbcnt_hi_u32_b32 %0, -1, %0" : "=v"(t_)); t_ += wv_ * 64; \
        F.ws = args.ws + z_; F.out = args.out + z_; F.tid = t_; F.lane = t_ & 63; F.wave = __builtin_amdgcn_readfirstlane(t_ >> 6); F.bid = b_; F.G = gridDim.x; \
        F.lds = (LAS unsigned char*)lds_raw + (unsigned)z_; F.inl = (volatile LAS unsigned long long*)(F.lds + MISC_OFF); }
#define PHASE(k, ...) if (lo <= (k) && (k) < hi) { { PH_FRAME(); __VA_ARGS__ } if ((k) + 1 < hi) GRID_BAR(); }

template <int l> __device__ __forceinline__ void ph_win(const Frame& F) {
    unsigned char* wl = F.ws + WS_WTS + (size_t)l * WTS_LAYER;
    pg8::Gemm g{(const bf16_t*)(F.ws + WS_XG), (const bf16_t*)(wl + WO_WIN), T, NIN, D}; pg8::StaticOrder S; S.init(T, NIN, F.G, F.bid);
    EpiIn E{F.ws, l};
    pg8::gemm_phase<EpiIn, pg8::StaticOrder>(F.lds, F.lds + HALO_OFF, g, S, E);
}
constexpr int CW_QUEUE = 16384, CW_CMPDONE = 8448, Q_ITEMS = 8 + 16 + 64;
template <int l> __device__ __forceinline__ void ph_mix(const Frame& F) {
    unsigned* ctl = (unsigned*)(F.ws + WS_CTL); unsigned* qhead = ctl + CW_QUEUE + 128 * l; unsigned* cmpdone = ctl + CW_CMPDONE + 64 * l;
    volatile LAS unsigned* slot = (volatile LAS unsigned*)(F.lds + MISC_OFF + 248);
    unsigned qoff = 0; const unsigned x0 = xb_xcc_id() & 7u;
    for (;;) {
        __syncthreads();
        if (F.tid == 0) { unsigned v, q;
            for (;;) { q = (x0 + qoff) & 7u; v = __hip_atomic_fetch_add(qhead + 16 * q, 1u, __ATOMIC_RELAXED, __HIP_MEMORY_SCOPE_AGENT); if (v < (unsigned)Q_ITEMS || qoff == 7u) break; ++qoff; }
            *slot = v < (unsigned)Q_ITEMS ? q * Q_ITEMS + v : 0xffffffffu; }
        __syncthreads();
        const unsigned its = *slot;
        if (its == 0xffffffffu) break;
        const int b = (int)(its / Q_ITEMS), li = (int)(its % Q_ITEMS);
        if (li < 8) { if (PHON(4)) cp::item(F, l, (li >> 2) * 32 + (2 * b + ((li >> 1) & 1)) * 2 + (li & 1), cmpdone); }
        else if (li < 24) { if (PHON(5)) lr::item(F, l, b * 16 + (li - 8)); }
        else { const int j = li - 24; if (PHON(6)) at::unit(F, l, 2 * b + (j & 1), 31 - (j >> 1), cmpdone); }
    }
}
template <int l> __device__ __forceinline__ void ph_wout(const Frame& F) {
    unsigned char* wl = F.ws + WS_WTS + (size_t)l * WTS_LAYER;
    pg8::Gemm g{(const bf16_t*)(F.ws + WS_MIXED), (const bf16_t*)(wl + WO_WOUT), T, D, D}; pg8::StaticOrder S; S.init(T, D, F.G, F.bid);
    for (int rep_ = 0; rep_ < REPS(3); ++rep_) {
    EpiRes<true, l == 0> E{l == 0 ? (const void*)INP(F, IN_X) : (const void*)(F.ws + WS_XB), F.ws, l * NB * 6144 + 2048, (l * 2 + 1) * NB * D, rep_ ? 1 : 0};
    pg8::gemm_phase<EpiRes<true, l == 0>, pg8::StaticOrder>(F.lds, F.lds + HALO_OFF, g, S, E); }
}
template <int l> __device__ __forceinline__ void ph_ffn1(const Frame& F) {
    unsigned char* wl = F.ws + WS_WTS + (size_t)l * WTS_LAYER;
    pg8::Gemm g{(const bf16_t*)(F.ws + WS_XG), (const bf16_t*)(wl + WO_WGU), T, NGU, D}; pg8::StaticOrder S; S.init(T, NGU, F.G, F.bid, 2);
    EpiGU E{F.ws, l};
    pg8::gemm_phase<EpiGU, pg8::StaticOrder>(F.lds, F.lds + HALO_OFF, g, S, E);
}
template <int l> __device__ __forceinline__ void ph_ffn2(const Frame& F) {
    unsigned char* wl = F.ws + WS_WTS + (size_t)l * WTS_LAYER;
    pg8::Gemm g{(const bf16_t*)(F.ws + WS_ACT), (const bf16_t*)(wl + WO_WDN), T, D, FF}; pg8::StaticOrder S; S.init(T, D, F.G, F.bid);
    {   pg8::Unit u; for (int i = 0; S.next(i, u); ++i) fix_rows(F, l, u.pm);
        asm volatile("s_waitcnt vmcnt(0)" ::: "memory"); __syncthreads(); }
    if (l + 1 < NL) {
        for (int rep_ = REPS(5) - 1; rep_ >= 0; --rep_) {
        EpiRes<false, false> E{(const void*)(F.ws + WS_XB), F.ws, l * NB * 6144 + 5120, (l + 1) * 2 * NB * D, rep_ ? 2 : 0};
        pg8::gemm_phase<EpiRes<false, false>, pg8::StaticOrder>(F.lds, F.lds + HALO_OFF, g, S, E); }
    } else {
        EpiFinal E{(const bf16_t*)(F.ws + WS_XB), F.out, F.ws, l * NB * 6144 + 5120, INP(F, IN_FING)};
        pg8::gemm_phase<EpiFinal, pg8::StaticOrder>(F.lds, F.lds + HALO_OFF, g, S, E);
    }
}
#define LAYER(l) \
    PHASE(2 + 5 * (l) + 0, for (int rep_ = 0; rep_ < REPS(0); ++rep_) { if (PHON(3)) ph_win<l>(F); }) \
    PHASE(2 + 5 * (l) + 1, ph_mix<l>(F);) \
    PHASE(2 + 5 * (l) + 2, if (PHON(9)) ph_wout<l>(F);) \
    PHASE(2 + 5 * (l) + 3, for (int rep_ = 0; rep_ < REPS(4); ++rep_) { if (PHON(10)) ph_ffn1<l>(F); }) \
    PHASE(2 + 5 * (l) + 4, if (PHON(12)) ph_ffn2<l>(F);)

__global__ void __launch_bounds__(512, 2) fwd_kernel(Args args) {
    extern __shared__ __attribute__((aligned(16))) unsigned char lds_raw[];
    if (threadIdx.x == 0) { volatile LAS unsigned long long* inl = (volatile LAS unsigned long long*)((LAS unsigned char*)lds_raw + MISC_OFF);
#pragma unroll
        for (int i = 0; i < 29; ++i) inl[i] = (unsigned long long)args.in[i];
        inl[30] = 0ull;
#if MK_ONE_LAUNCH && !MK_CG_BARRIER
        (void)xb_add((unsigned*)(args.ws + WS_CTL) + 4096 + XB_XCNT(xb_xcc_id()), 1u);
#endif
    }
    __syncthreads();
#if MK_ONE_LAUNCH && MK_CG_BARRIER
    cg::grid_group grid = cg::this_grid();
#define GRID_BAR() grid.sync()
#elif MK_ONE_LAUNCH
    unsigned* xbar = (unsigned*)(args.ws + WS_CTL) + 4096;
    volatile LAS unsigned* xst = (volatile LAS unsigned*)((LAS unsigned char*)lds_raw + MISC_OFF + 240);
#define GRID_BAR() xcd_barrier(xbar, xst)
#else
#define GRID_BAR() do { } while (0)
#endif
    const int wave0 = __builtin_amdgcn_readfirstlane(threadIdx.x >> 6);
    const int lo = args.ph_lo, hi = args.ph_hi;
    PHASE(0, for (int rep_ = 0; rep_ < REPS(100); ++rep_) { if (PHON(0)) { ph_mod(F); ph_convert(F); ph_posp(F); } })
    PHASE(1, for (int rep_ = 0; rep_ < REPS(101); ++rep_) { if (PHON(1)) ph_prep(F); })
    LAYER(0) LAYER(1) LAYER(2) LAYER(3)
}

extern "C" void kernel_launch(void* const* d_in, const int* in_sizes, int n_in, void* d_out, int out_size, void* d_ws, size_t ws_size, hipStream_t stream) {
    static int grid = 0;
    if (grid == 0) {
        if (n_in != 29 || out_size != T * D || ws_size < WS_END) { fprintf(stderr, "kernel_launch: unexpected problem (n_in %d out %d ws %zu)\n", n_in, out_size, ws_size); grid = -1; return; }
        int dev = 0, cus = 0, per_cu = 0;
        hipGetDevice(&dev); hipDeviceGetAttribute(&cus, hipDeviceAttributeMultiprocessorCount, dev);
        if (hipFuncSetAttribute((const void*)fwd_kernel, hipFuncAttributeMaxDynamicSharedMemorySize, LDS_BYTES) != hipSuccess) { fprintf(stderr, "kernel_launch: hipFuncSetAttribute failed\n"); grid = -1; return; }
        hipOccupancyMaxActiveBlocksPerMultiprocessor(&per_cu, (const void*)fwd_kernel, 512, LDS_BYTES);
        (void)hipGetLastError();
        if (per_cu < 1) fprintf(stderr, "kernel_launch: occupancy query says %d\n", per_cu);
        grid = cus;
    }
    if (grid < 0) return;
    Args a{};
    for (int i = 0; i < 29; ++i) a.in[i] = (const float*)d_in[i];
    a.out = (float*)d_out; a.ws = (unsigned char*)d_ws;
#if MK_ONE_LAUNCH
    a.ph_lo = 0; a.ph_hi = N_PHASES;
#if MK_CG_BARRIER
    void* kargs[] = {&a};
    hipError_t e = hipLaunchCooperativeKernel((const void*)fwd_kernel, dim3(grid), dim3(512), kargs, LDS_BYTES, stream);
    if (e != hipSuccess) fprintf(stderr, "cooperative launch failed: %s\n", hipGetErrorString(e));
#else
    if (hipMemsetAsync((char*)d_ws + WS_CTL, 0, CTL_ZERO_BYTES, stream) != hipSuccess) { fprintf(stderr, "kernel_launch: memset failed\n"); return; }
    hipLaunchKernelGGL(fwd_kernel, dim3(grid), dim3(512), LDS_BYTES, stream, a);
#endif
#else
    for (int ph = 0; ph < N_PHASES; ++ph) { a.ph_lo = ph; a.ph_hi = ph + 1; hipLaunchKernelGGL(fwd_kernel, dim3(grid), dim3(512), LDS_BYTES, stream, a); }
#endif
}
```

```cpp
#include <hip/hip_runtime.h>
#include <cstdio>
#include <cstdint>

#ifndef MK_ONE_LAUNCH
#define MK_ONE_LAUNCH 1
#endif
#ifndef MK_CG_BARRIER
#define MK_CG_BARRIER 0
#endif
#if MK_ONE_LAUNCH && MK_CG_BARRIER
#include <hip/hip_cooperative_groups.h>
namespace cg = cooperative_groups;
#endif

#define LAS __attribute__((address_space(3)))
typedef unsigned short bf16_t;
typedef short bf16x8 __attribute__((ext_vector_type(8)));
typedef float f32x4 __attribute__((ext_vector_type(4)));
typedef float f32x2 __attribute__((ext_vector_type(2)));
typedef unsigned u32x4 __attribute__((ext_vector_type(4)));
typedef unsigned u32x2 __attribute__((ext_vector_type(2)));

constexpr int NB = 8, SEQ = 2048, T = NB * SEQ, D = 1024, NL = 4, FF = 2816;
constexpr int NIN = 2560;
constexpr int NINSRC = 2328;
constexpr int NGU = 2 * FF;
constexpr float EPS = 1e-6f;
constexpr float C2 = 0.125f * 1.4426950408889634f;
constexpr float LOG2E = 1.4426950408889634f;

constexpr size_t MiB = 1u << 20;
constexpr size_t WS_CTL = 0, CTL_ZERO_BYTES = 1 * MiB;
constexpr size_t WS_MOD = 1 * MiB;
constexpr size_t WS_SHW1 = 2 * MiB;
constexpr size_t WS_SHWG = 3 * MiB;
constexpr size_t WS_ROWSS = 4 * MiB;
constexpr size_t WS_SSN = 5 * MiB;
constexpr size_t WS_SSL = 6 * MiB;
constexpr size_t WS_LRUA = WS_SSL;
constexpr size_t WS_GS = 7 * MiB;
constexpr size_t WS_POSB = 7 * MiB + 512 * 1024;
constexpr size_t WS_POSP = 7 * MiB + 576 * 1024;
constexpr size_t WS_KCMP = 8 * MiB;
constexpr size_t WS_FCW = 9 * MiB;
constexpr size_t WS_GFIRST = 10 * MiB, WS_GLAST = 12 * MiB, WS_UFIRST = 14 * MiB;
constexpr size_t WS_ZG = 16 * MiB;
constexpr size_t WS_WTS = 20 * MiB, WTS_LAYER = 27 * MiB;
constexpr size_t WO_WIN = 0, WO_WOUT = 5 * MiB, WO_WGU = 7 * MiB, WO_WDN = 18 * MiB, WO_CW1 = 24 * MiB, WO_CW2 = 26 * MiB, WO_LRUW = 26 * MiB + 256 * 1024;
constexpr size_t WS_XG = 128 * MiB;
constexpr size_t WS_Q = 160 * MiB;
constexpr size_t WS_KV = 166 * MiB, KV_STRIDE = MiB / 2;
constexpr size_t WS_ZX = 162 * MiB, WS_ZY = 164 * MiB;
constexpr size_t CH_Q = 9 * MiB, CH_KV = 11 * MiB - MiB / 2;
static_assert(CH_KV == 42 * (size_t)2048 * 64 * 2 && CH_Q == (size_t)9216 * 512 * 2, "chunk strides");
constexpr size_t WS_OWIN = 238 * MiB;
constexpr size_t WS_MIXED = 254 * MiB;
constexpr size_t WS_ACT = 160 * MiB;
constexpr size_t WS_XB = 286 * MiB;
constexpr size_t WS_END = 318 * MiB;

constexpr int RING_BYTES = 131072, HALO_OFF = RING_BYTES, HALO_BYTES = 16384, MISC_OFF = HALO_OFF + HALO_BYTES, RSTD_OFF = MISC_OFF + 256, LDS_BYTES = RSTD_OFF + 1024 + 256;
constexpr int CW_GROUPBAR = 16384, CW_GROUPMASK = 17408, CW_Z2 = 20480;
constexpr int CW_PDONE = 22528, CW_LDONE = 38912, CW_WQ = 39424;
__device__ __forceinline__ unsigned group_mode(unsigned char* ws, volatile LAS unsigned* gst) {
    unsigned mode = *gst;
    if (mode == 0u) { const unsigned xm = __hip_atomic_load((unsigned*)(ws + WS_CTL) + CW_GROUPMASK + 64 * (blockIdx.x & 7), __ATOMIC_RELAXED, __HIP_MEMORY_SCOPE_AGENT); mode = (xm & (xm - 1u)) != 0u ? 2u : 1u; *gst = mode; }
    return mode;
}
__device__ __forceinline__ void group_release(unsigned mode) { if (mode != 1u) { __builtin_amdgcn_fence(__ATOMIC_RELEASE, "agent"); asm volatile("s_waitcnt vmcnt(0)" ::: "memory"); } }
__device__ __forceinline__ void group_acquire(unsigned mode) { if (mode != 1u) __builtin_amdgcn_fence(__ATOMIC_ACQUIRE, "agent"); else asm volatile("buffer_inv sc0" ::: "memory"); asm volatile("s_waitcnt vmcnt(0)" ::: "memory"); }

__device__ __forceinline__ float bf2f(unsigned v) { return __uint_as_float(v << 16); }
__device__ __forceinline__ unsigned f2bf(float f) { unsigned u = __float_as_uint(f); return (u + 0x7fffu + ((u >> 16) & 1u)) >> 16; }
__device__ __forceinline__ unsigned pk2(float lo, float hi) { return f2bf(lo) | (f2bf(hi) << 16); }
__device__ __forceinline__ unsigned cvt_pk_bf16(float lo, float hi) { unsigned r; asm volatile("v_cvt_pk_bf16_f32 %0, %1, %2" : "=v"(r) : "v"(lo), "v"(hi)); return r; }
__device__ __forceinline__ void unpack8(const u32x4 v, float* o) {
    o[0] = __uint_as_float(v.x << 16); o[1] = __uint_as_float(v.x & 0xffff0000u); o[2] = __uint_as_float(v.y << 16); o[3] = __uint_as_float(v.y & 0xffff0000u);
    o[4] = __uint_as_float(v.z << 16); o[5] = __uint_as_float(v.z & 0xffff0000u); o[6] = __uint_as_float(v.w << 16); o[7] = __uint_as_float(v.w & 0xffff0000u);
}
__device__ __forceinline__ float sigmoidf_(float x) { return __builtin_amdgcn_rcpf(1.0f + __builtin_amdgcn_exp2f(-1.4426950408889634f * x)); }
__device__ __forceinline__ float siluf_(float x) { return x * __builtin_amdgcn_rcpf(1.0f + __builtin_amdgcn_exp2f(-1.4426950408889634f * x)); }
__device__ __forceinline__ float gelu_tanh(float x) { const float y2 = (2.0f * LOG2E * 0.7978845608028654f) * (x + 0.044715f * x * x * x); return x - x * __builtin_amdgcn_rcpf(1.0f + __builtin_amdgcn_exp2f(y2)); }
__device__ __forceinline__ float wave_sum(float v) {
#pragma unroll
    for (int o = 1; o < 64; o <<= 1) v += __shfl_xor(v, o);
    return v;
}
#define LDS_WAIT() asm volatile("s_waitcnt lgkmcnt(0)" ::: "memory")
__device__ __forceinline__ void st16_wt(void* p, const u32x4 v) { asm volatile("global_store_dwordx4 %0, %1, off\n\ts_nop 1" :: "v"(p), "v"(v) : "memory"); }

namespace pg8 {
constexpr int BM = 256, BK = 64, HALF = 128, HTB = HALF * BK * 2, STAGE_BYTES = 8 * HTB, NXCD = 8, WGM = 4;
__host__ __device__ __forceinline__ int lds_byte(int r, int c) { const int st = (r >> 4) * 2 + (c >> 5), rr = r & 15, cc = c & 31, ob = rr * 64 + cc * 2; return st * 1024 + (ob ^ (((ob >> 9) & 1) << 5)); }
__host__ __device__ __forceinline__ void stage_rc(int b, int& R, int& C) { const int st = b / 1024, sb = b % 1024, swz = sb ^ (((sb >> 9) & 1) << 5); R = (st >> 1) * 16 + swz / 64; C = (st & 1) * 32 + (swz % 64) / 2; }
__host__ __device__ __forceinline__ int perm32(int rho) { const int n = rho >> 4, i = rho & 15; return 8 * (i >> 2) + 4 * n + (i & 3); }
struct Unit { int pm, pn; };
struct Gemm { const bf16_t* A; const bf16_t* Bt; int M, N, K; };
struct StaticOrder {
    int nM, nN, nwg, G, c, wgm, zf;
    __host__ __device__ void init(int M, int N, int G_, int c_, int wgm_ = WGM) { nM = M / BM; nN = N / BM; nwg = nM * nN; G = G_; c = c_; wgm = wgm_; zf = 0; }
    __host__ __device__ bool next(int i, Unit& u) const {
        const long L = (long)i * G + c; if (L >= nwg) return false;
        int wgid = (int)L; { const int q = nwg / NXCD, r = nwg % NXCD, xcd = wgid % NXCD, off = wgid / NXCD; wgid = (xcd < r ? xcd * (q + 1) : r * (q + 1) + (xcd - r) * q) + off; }
        const int nig = wgm * nN, gid = wgid / nig, fm = gid * wgm, gsz = (nM - fm) < wgm ? (nM - fm) : wgm;
        u.pm = fm + ((wgid % nig) % gsz); u.pn = (wgid % nig) / gsz; if (zf) u.pn = u.pn < 4 ? u.pn + 5 : (u.pn < 9 ? u.pn - 4 : 9); return true;
    }
};
template <class Epi, class Sched, bool ALIGN_EPI = true, bool SP2 = true>
__device__ __forceinline__ void gemm_phase(LAS unsigned char* lds, LAS unsigned char* ldsx, const Gemm g, const Sched& S, const Epi& E, int tid_in) {
    int tid_ = tid_in; asm volatile("" : "+v"(tid_));
    const int tid = tid_, wid = __builtin_amdgcn_readfirstlane(tid >> 6), lane = tid & 63, wr = wid >> 2, wc = wid & 3, fr = lane & 15, fq = lane >> 4;
    const int K = g.K, nt = K / BK;
    unsigned voffA[2], voffB[2];
#pragma unroll
    for (int i = 0; i < 2; ++i) { int R, C; stage_rc(tid * 16 + i * 8192, R, C); const int Rb = Epi::PERM ? ((R & ~31) + perm32(R & 31)) : R;
        voffA[i] = (unsigned)(R * K + C) * 2u; voffB[i] = (unsigned)(Rb * K + C) * 2u; }
    const size_t kstep = (size_t)(BK * 2);
    const size_t hstep = (size_t)HALF * K * 2;
    const size_t tstep = 2 * hstep;
    const unsigned ldsw = (unsigned)wid * 1024u;
    const int aoff = lds_byte(wr * 64 + fr, fq * 8), boff = lds_byte(wc * 32 + fr, fq * 8);
#define PG8_SA(b, h) (((b) * 2 + (h)) * HTB)
#define PG8_SB(b, h) ((4 + (b) * 2 + (h)) * HTB)
#define PG8_STAGE(bufoff, gbase, voff) do { _Pragma("unroll") for (int _i = 0; _i < 2; ++_i) \
        __builtin_amdgcn_global_load_lds((const unsigned*)((const char*)(gbase) + (voff)[_i]), (LAS unsigned*)(lds + (bufoff) + ldsw + _i * 8192), 16, 0, 0); } while (0)
#define PG8_LDA(dst, b, h) do { _Pragma("unroll") for (int m = 0; m < 4; ++m) _Pragma("unroll") for (int k = 0; k < 2; ++k) dst[m][k] = *(const LAS bf16x8*)(lds + PG8_SA(b, h) + aoff + m * 2048 + k * 1024); } while (0)
#define PG8_LDB(dst, b, h) do { _Pragma("unroll") for (int n = 0; n < 2; ++n) _Pragma("unroll") for (int k = 0; k < 2; ++k) dst[n][k] = *(const LAS bf16x8*)(lds + PG8_SB(b, h) + boff + n * 2048 + k * 1024); } while (0)
#define PG8_MMA(ai, bj, At, Bt) do { __builtin_amdgcn_s_setprio(1); _Pragma("unroll") for (int m = 0; m < 4; ++m) _Pragma("unroll") for (int n = 0; n < 2; ++n) _Pragma("unroll") for (int k = 0; k < 2; ++k) \
        acc[ai][bj][m][n] = __builtin_amdgcn_mfma_f32_16x16x32_bf16(Bt[n][k], At[m][k], acc[ai][bj][m][n], 0, 0, 0); __builtin_amdgcn_s_setprio(0); } while (0)
#define PG8_WAIT_V(n) asm volatile("s_waitcnt vmcnt(" #n ")" ::: "memory")
#define PG8_WAIT_L(n) asm volatile("s_waitcnt lgkmcnt(" #n ")" ::: "memory")
#define PG8_BAR __builtin_amdgcn_s_barrier()
#define PG8_SCHED __builtin_amdgcn_sched_barrier(0)
    Unit cur, nxt; int ui = 0;
    if (!S.next(0, cur)) return;
    f32x4 acc[2][2][4][2];
#pragma unroll
    for (int a = 0; a < 2; ++a)
#pragma unroll
        for (int b = 0; b < 2; ++b)
#pragma unroll
            for (int m = 0; m < 4; ++m)
#pragma unroll
                for (int n = 0; n < 2; ++n) acc[a][b][m][n] = (f32x4){0.f, 0.f, 0.f, 0.f};
    bf16x8 At[4][2], B0[2][2], B1[2][2];
    const char* cA = (const char*)g.A + (size_t)cur.pm * tstep; const char* cB = (const char*)g.Bt + (size_t)cur.pn * tstep;
    typename Epi::PreRegs pregs;
    if constexpr (Epi::PRE) E.pre_issue(pregs, cur.pm, wid, lane);
    if constexpr (SP2) {
        PG8_STAGE(PG8_SB(0, 0), cB, voffB); PG8_STAGE(PG8_SB(0, 1), cB + hstep, voffB); PG8_STAGE(PG8_SA(0, 0), cA, voffA); PG8_STAGE(PG8_SA(0, 1), cA + hstep, voffA);
        if (wr == 1) PG8_BAR;
        PG8_WAIT_V(2); PG8_BAR;
        if constexpr (Epi::PRE) E.pre_commit(pregs, ldsx, wid, lane);
        PG8_STAGE(PG8_SB(1, 0), cB + kstep, voffB); PG8_STAGE(PG8_SA(1, 0), cA + kstep, voffA); PG8_STAGE(PG8_SB(1, 1), cB + hstep + kstep, voffB);
        PG8_WAIT_V(6); PG8_BAR;
    } else {
        PG8_STAGE(PG8_SB(0, 0), cB, voffB); PG8_STAGE(PG8_SA(0, 0), cA, voffA); PG8_STAGE(PG8_SB(0, 1), cB + hstep, voffB); PG8_STAGE(PG8_SA(0, 1), cA + hstep, voffA);
        if (wr == 1) PG8_BAR;
        PG8_WAIT_V(4); PG8_BAR;
        if constexpr (Epi::PRE) E.pre_commit(pregs, ldsx, wid, lane);
        PG8_STAGE(PG8_SB(1, 0), cB + kstep, voffB); PG8_STAGE(PG8_SA(1, 0), cA + kstep, voffA); PG8_STAGE(PG8_SB(1, 1), cB + hstep + kstep, voffB);
        PG8_WAIT_V(6); PG8_BAR;
    }
    for (;;) {
        const bool has_next = S.next(ui + 1, nxt);
        const char* nA = has_next ? (const char*)g.A + (size_t)nxt.pm * tstep : cA; const char* nB = has_next ? (const char*)g.Bt + (size_t)nxt.pn * tstep : cB;
        for (int t = 0; t < nt; t += 2) {
            const bool last = (t == nt - 2);
            const char* a1 = cA + (size_t)(t + 1) * kstep;
            const char* a2 = last ? nA : cA + (size_t)(t + 2) * kstep; const char* b2 = last ? nB : cB + (size_t)(t + 2) * kstep;
            const char* a3 = a2 + kstep; const char* b3 = b2 + kstep;
            if constexpr (Epi::MIDK) { if (t == (nt >> 1)) E.midk(acc, cur, wr, fr, ldsx); }
            if constexpr (SP2) {
            PG8_LDB(B0, 0, 0); PG8_LDB(B1, 0, 1); PG8_SCHED; PG8_LDA(At, 0, 0); PG8_STAGE(PG8_SA(1, 1), a1 + hstep, voffA);
            PG8_WAIT_V(8); PG8_WAIT_L(0); PG8_BAR; PG8_MMA(0, 0, At, B0); PG8_MMA(0, 1, At, B1); PG8_BAR; PG8_SCHED;
            PG8_LDA(At, 0, 1); PG8_STAGE(PG8_SB(0, 0), b2, voffB); PG8_STAGE(PG8_SB(0, 1), b2 + hstep, voffB); PG8_STAGE(PG8_SA(0, 0), a2, voffA);
            PG8_WAIT_V(8); PG8_WAIT_L(0); PG8_BAR; PG8_MMA(1, 0, At, B0); PG8_MMA(1, 1, At, B1); PG8_BAR; PG8_SCHED;
            PG8_LDB(B0, 1, 0); PG8_LDB(B1, 1, 1); PG8_SCHED; PG8_LDA(At, 1, 0); PG8_STAGE(PG8_SA(0, 1), a2 + hstep, voffA);
            PG8_WAIT_V(8); PG8_WAIT_L(0); PG8_BAR; PG8_MMA(0, 0, At, B0); PG8_MMA(0, 1, At, B1); PG8_BAR; PG8_SCHED;
            PG8_LDA(At, 1, 1); PG8_STAGE(PG8_SB(1, 0), b3, voffB); PG8_STAGE(PG8_SB(1, 1), b3 + hstep, voffB); PG8_STAGE(PG8_SA(1, 0), a3, voffA);
            PG8_WAIT_V(8); PG8_WAIT_L(0); PG8_BAR; PG8_MMA(1, 0, At, B0); PG8_MMA(1, 1, At, B1); PG8_BAR; PG8_SCHED;
            } else {
            PG8_LDB(B0, 0, 0); PG8_SCHED; PG8_LDA(At, 0, 0); PG8_STAGE(PG8_SA(1, 1), a1 + hstep, voffA);
            PG8_WAIT_L(8); PG8_BAR; PG8_WAIT_L(0); PG8_MMA(0, 0, At, B0); PG8_BAR; PG8_SCHED;
            PG8_LDB(B1, 0, 1); PG8_STAGE(PG8_SB(0, 0), b2, voffB);
            PG8_BAR; PG8_WAIT_L(0); PG8_MMA(0, 1, At, B1); PG8_BAR;
            PG8_LDA(At, 0, 1); PG8_STAGE(PG8_SA(0, 0), a2, voffA);
            PG8_BAR; PG8_WAIT_L(0); PG8_MMA(1, 0, At, B0); PG8_BAR; PG8_SCHED;
            PG8_STAGE(PG8_SB(0, 1), b2 + hstep, voffB);
            PG8_WAIT_V(6); PG8_BAR; PG8_MMA(1, 1, At, B1); PG8_BAR;
            PG8_LDB(B0, 1, 0); PG8_SCHED; PG8_LDA(At, 1, 0); PG8_STAGE(PG8_SA(0, 1), a2 + hstep, voffA);
            PG8_WAIT_L(8); PG8_BAR; PG8_WAIT_L(0); PG8_MMA(0, 0, At, B0); PG8_BAR; PG8_SCHED;
            PG8_LDB(B1, 1, 1); PG8_STAGE(PG8_SB(1, 0), b3, voffB);
            PG8_BAR; PG8_WAIT_L(0); PG8_MMA(0, 1, At, B1); PG8_BAR;
            PG8_LDA(At, 1, 1); PG8_STAGE(PG8_SA(1, 0), a3, voffA);
            PG8_BAR; PG8_WAIT_L(0); PG8_MMA(1, 0, At, B0); PG8_BAR; PG8_SCHED;
            PG8_STAGE(PG8_SB(1, 1), b3 + hstep, voffB);
            PG8_WAIT_V(6); PG8_BAR; PG8_MMA(1, 1, At, B1); PG8_BAR;
            }
        }
        if constexpr (ALIGN_EPI) { if (wr == 0) PG8_BAR; }
        E(acc, cur, wr, wc, fr, fq, ldsx, wid, lane, ui & 1, has_next ? nxt.pm : -1);
        if constexpr (Epi::POST) { if (ui == 1) { asm volatile("s_waitcnt vmcnt(0)" ::: "memory"); __builtin_amdgcn_s_barrier(); asm volatile("" ::: "memory"); if (tid == 0) E.post(ldsx); } }
        if (!has_next) break;
#pragma unroll
        for (int a = 0; a < 2; ++a)
#pragma unroll
            for (int b = 0; b < 2; ++b)
#pragma unroll
                for (int m = 0; m < 4; ++m)
#pragma unroll
                    for (int n = 0; n < 2; ++n) acc[a][b][m][n] = (f32x4){0.f, 0.f, 0.f, 0.f};
        cur = nxt; cA = nA; cB = nB; ++ui;
        if constexpr (ALIGN_EPI) { if (wr == 1) PG8_BAR; }
    }
    PG8_WAIT_V(0);
    if constexpr (!ALIGN_EPI) { if (wr == 0) PG8_BAR; }
    PG8_BAR;
#undef PG8_SA
#undef PG8_SB
#undef PG8_STAGE
#undef PG8_LDA
#undef PG8_LDB
#undef PG8_MMA
#undef PG8_WAIT_V
#undef PG8_WAIT_L
#undef PG8_BAR
#undef PG8_SCHED
}
}

__device__ __forceinline__ float row_rstd(const float* rowss, int row, int fq) {
    const f32x4 p = *(const f32x4*)(rowss + (size_t)row * 16 + fq * 4);
    float s = (p.x + p.y) + (p.z + p.w);
    s += __shfl_xor(s, 16); s += __shfl_xor(s, 32);
    return rsqrtf(s * (1.0f / D) + EPS);
}

struct RstdAhead { f32x4 v0, v1; };
__device__ __forceinline__ void rstd_issue(RstdAhead& r, const float* rowss, int pm, int tid) {
    const float* p = rowss + ((size_t)pm * 256 + (tid >> 2)) * 16 + (tid & 3) * 4; r.v0 = *(const f32x4*)p; r.v1 = *(const f32x4*)(p + 128 * 16);
}
__device__ __forceinline__ void rstd_commit(const RstdAhead& r, LAS float* tab, int tid) {
    float s0 = (r.v0.x + r.v0.y) + (r.v0.z + r.v0.w), s1 = (r.v1.x + r.v1.y) + (r.v1.z + r.v1.w);
    s0 += __shfl_xor(s0, 1); s1 += __shfl_xor(s1, 1); s0 += __shfl_xor(s0, 2); s1 += __shfl_xor(s1, 2);
    if ((tid & 3) == 0) { tab[tid >> 2] = rsqrtf(s0 * (1.0f / D) + EPS); tab[128 + (tid >> 2)] = rsqrtf(s1 * (1.0f / D) + EPS); }
}
__device__ __forceinline__ void rstd_pre(const float* rowss, int pm, LAS unsigned char* ldsx, int wid, int lane) {
    RstdAhead r; rstd_issue(r, rowss, pm, wid * 64 + lane); rstd_commit(r, (LAS float*)(ldsx + 4096), wid * 64 + lane);
    LDS_WAIT(); __builtin_amdgcn_s_barrier(); asm volatile("" ::: "memory");
}
__device__ __forceinline__ LAS float* rstd_table(const float* rowss, int pm, LAS unsigned char* ldsx, int wid, int lane) {
    LAS float* tab = (LAS float*)(ldsx + (RSTD_OFF - HALO_OFF));
    if (wid < 4) { const int r = wid * 64 + lane; const f32x4* p = (const f32x4*)(rowss + ((size_t)pm * 256 + r) * 16); const f32x4 a = p[0], b = p[1], c = p[2], d = p[3];
        const float sm = ((a.x + a.y) + (a.z + a.w)) + ((b.x + b.y) + (b.z + b.w)) + ((c.x + c.y) + (c.z + c.w)) + ((d.x + d.y) + (d.z + d.w));
        tab[r] = rsqrtf(sm * (1.0f / D) + EPS); }
    LDS_WAIT(); __builtin_amdgcn_s_barrier(); asm volatile("" ::: "memory");
    return tab;
}

struct EpiIn {
    static constexpr bool PERM = true, MIDK = false, PRE = true, POST = true;
    unsigned char* ws; int l;
    __device__ __forceinline__ void post(LAS unsigned char* ldsx) const {
        group_release(group_mode(ws, (volatile LAS unsigned*)(ldsx + HALO_BYTES + 232)));
        __hip_atomic_fetch_add((unsigned*)(ws + WS_CTL) + CW_Z2 + 64 * (l * 8 + (int)(blockIdx.x & 7)), 1u, __ATOMIC_RELAXED, __HIP_MEMORY_SCOPE_AGENT); }
    typedef RstdAhead PreRegs;
    __device__ __forceinline__ void pre_issue(PreRegs& r, int pm, int wid, int lane) const { rstd_issue(r, (const float*)(ws + WS_ROWSS), pm, wid * 64 + lane); }
    __device__ __forceinline__ void pre_commit(const PreRegs& r, LAS unsigned char* ldsx, int wid, int lane) const { rstd_commit(r, (LAS float*)(ldsx + 4096), wid * 64 + lane); }
    __device__ __forceinline__ void operator()(const f32x4 (&acc)[2][2][4][2], const pg8::Unit& u, int wr, int wc, int fr, int fq, LAS unsigned char* ldsx, int wid, int lane, int par, int nxt_pm) const {
        asm volatile("" : "+v"(fr), "+v"(fq), "+v"(lane));
        RstdAhead ra; if (nxt_pm >= 0) rstd_issue(ra, (const float*)(ws + WS_ROWSS), nxt_pm, wid * 64 + lane);
        const float* shw = (const float*)(ws + WS_SHW1) + (size_t)l * NB * NIN; bf16_t* Q = (bf16_t*)(ws + WS_Q); bf16_t* KV = (bf16_t*)(ws + WS_KV);
        bf16_t* ZX = (bf16_t*)(ws + WS_ZX); bf16_t* ZY = (bf16_t*)(ws + WS_ZY); float* ZG = (float*)(ws + WS_ZG);
        const int b = u.pm >> 3, cin = wc * 32 + 8 * fq, row0 = u.pm * 256 + wr * 64 + fr;
        Q += (size_t)b * (CH_Q / 2); ZX += (size_t)b * (CH_Q / 2); ZY += (size_t)b * (CH_Q / 2); KV += (size_t)b * (CH_KV / 2);
        f32x4 bv[2][2];
#pragma unroll
        for (int bj = 0; bj < 2; ++bj)
#pragma unroll
            for (int n = 0; n < 2; ++n) bv[bj][n] = *(const f32x4*)(shw + b * NIN + u.pn * 256 + bj * 128 + cin + 4 * n);
        const LAS float* rtab = (const LAS float*)(ldsx + 4096 + 1024 * par);
#pragma unroll
        for (int ai = 0; ai < 2; ++ai)
#pragma unroll
            for (int m = 0; m < 4; ++m) {
                const int row = row0 + ai * 128 + m * 16;
                const float rs = rtab[ai * 128 + wr * 64 + m * 16 + fr];
#pragma unroll
                for (int bj = 0; bj < 2; ++bj) {
                    f32x4 v0 = acc[ai][bj][m][0] * rs + bv[bj][0], v1 = acc[ai][bj][m][1] * rs + bv[bj][1];
                    const int col = u.pn * 256 + bj * 128 + cin;
                    if (u.pn < 2) { v0 = v0 * C2; v1 = v1 * C2; }
                    u32x4 w; w.x = cvt_pk_bf16(v0[0], v0[1]); w.y = cvt_pk_bf16(v0[2], v0[3]); w.z = cvt_pk_bf16(v1[0], v1[1]); w.w = cvt_pk_bf16(v1[2], v1[3]);
                    if (u.pn < 2) st16_wt(Q + (size_t)row * 512 + col, w);
                    else if (u.pn < 5) { const int c2 = col - 512, arr = c2 >> 7, wi = c2 & 127, g = wi >> 6, d = wi & 63, t = row & (SEQ - 1);
                        st16_wt(KV + (size_t)arr * (KV_STRIDE / 2) + ((size_t)((b * 2 + g) * SEQ + t) * 64 + d), w); }
                    else if (u.pn < 7) st16_wt(ZX + (size_t)row * 512 + (col - 1280), w);
                    else if (u.pn < 9) st16_wt(ZY + (size_t)row * 512 + (col - 1792), w);
                    else { const int c = col - 2304; if (c < 24) { *(f32x4*)(ZG + (size_t)row * 24 + c) = v0; *(f32x4*)(ZG + (size_t)row * 24 + c + 4) = v1; } }
                }
            }
        if (nxt_pm >= 0) rstd_commit(ra, (LAS float*)(ldsx + 4096 + 1024 * (par ^ 1)), wid * 64 + lane);
    }
};

template <bool MIDK_, bool BF32> struct EpiRes {
    static constexpr bool PERM = true, MIDK = MIDK_, PRE = MIDK_, POST = false;
    struct PreRegs { f32x2 sn; f32x4 a, b, c, d; };
    __device__ __forceinline__ void pre_issue(PreRegs& r, int pm, int wid, int lane) const { const int t = wid * 64 + lane; const size_t row = (size_t)pm * 256 + (t & 255);
        r.sn = *(const f32x2*)((const float*)(ws + WS_SSN) + row * 2); const f32x4* pl = (const f32x4*)((const float*)(ws + WS_SSL) + row * 16); r.a = pl[0]; r.b = pl[1]; r.c = pl[2]; r.d = pl[3]; }
    __device__ __forceinline__ void pre_commit(const PreRegs& r, LAS unsigned char* ldsx, int wid, int lane) const { const int t = wid * 64 + lane;
        const float sl = ((r.a.x + r.a.y) + (r.a.z + r.a.w)) + ((r.b.x + r.b.y) + (r.b.z + r.b.w)) + ((r.c.x + r.c.y) + (r.c.z + r.c.w)) + ((r.d.x + r.d.y) + (r.d.z + r.d.w));
        const float rn = rsqrtf((r.sn.x + r.sn.y) * (1.0f / 512.0f) + EPS), rl = rsqrtf(sl * (1.0f / 512.0f) + EPS);
        if (t < 256) ((LAS f32x2*)ldsx)[t] = (f32x2){rn / rl, rl}; }
    const void* base; unsigned char* ws; int goff; int gsoff; int dry;
    __device__ __forceinline__ void midk(f32x4 (&acc)[2][2][4][2], const pg8::Unit& u, int wr, int fr, LAS unsigned char* ldsx) const {
        asm volatile("" : "+v"(fr));
        const LAS f32x2* rs2 = (const LAS f32x2*)ldsx;
#pragma unroll
        for (int ai = 0; ai < 2; ++ai)
#pragma unroll
            for (int m = 0; m < 4; ++m) { const float s = rs2[ai * 128 + wr * 64 + m * 16 + fr].x;
#pragma unroll
                for (int bj = 0; bj < 2; ++bj)
#pragma unroll
                    for (int n = 0; n < 2; ++n) acc[ai][bj][m][n] = acc[ai][bj][m][n] * s; }
    }
    __device__ __forceinline__ void operator()(const f32x4 (&acc)[2][2][4][2], const pg8::Unit& u, int wr, int wc, int fr, int fq, LAS unsigned char* ldsx, int, int, int, int) const {
        run(acc, u, wr, wc, fr, fq, ldsx, dry);
#if REP_SUB == 7
        run(acc, u, wr, wc, fr, fq, ldsx, MIDK ? 1 : 2);
#endif
    }
    __device__ __forceinline__ void run(const f32x4 (&acc)[2][2][4][2], const pg8::Unit& u, int wr, int wc, int fr, int fq, LAS unsigned char* ldsx, int dry) const {
        asm volatile("" : "+v"(fr), "+v"(fq));
        const LAS f32x2* rs2 = (const LAS f32x2*)ldsx;
        const float* gate = (const float*)(ws + WS_MOD) + goff; const float* gsn = (const float*)(ws + WS_GS) + gsoff;
        bf16_t* XG = (bf16_t*)(ws + (dry ? (dry == 1 ? WS_ZX : WS_MIXED) : WS_XG)); bf16_t* XB = (bf16_t*)(ws + (dry ? (dry == 1 ? WS_Q : WS_MIXED) : WS_XB)); float* rowss = (float*)(ws + (dry ? WS_LRUA : WS_ROWSS));
        const float* basef = (const float*)base; const bf16_t* baseb = (const bf16_t*)base;
        const int b = u.pm >> 3, col0 = u.pn * 256 + wc * 32 + 8 * fq;
        f32x4 gv[2][2], gs[2][2];
#pragma unroll
        for (int bj = 0; bj < 2; ++bj)
#pragma unroll
            for (int n = 0; n < 2; ++n) { gv[bj][n] = *(const f32x4*)(gate + (size_t)b * 6144 + col0 + bj * 128 + n * 4); gs[bj][n] = *(const f32x4*)(gsn + (size_t)b * D + col0 + bj * 128 + n * 4); }
        f32x4 pre[2][2][2]; u32x4 prb[4][2];
        {   const size_t off0 = (size_t)(u.pm * 256 + wr * 64 + fr) * D + col0;
            if constexpr (BF32) {
#pragma unroll
                for (int bj = 0; bj < 2; ++bj) { pre[0][bj][0] = *(const f32x4*)(basef + off0 + bj * 128); pre[0][bj][1] = *(const f32x4*)(basef + off0 + bj * 128 + 4); }
            } else {
#pragma unroll
                for (int g8 = 0; g8 < 4; ++g8)
#pragma unroll
                    for (int bj = 0; bj < 2; ++bj) prb[g8][bj] = *(const u32x4*)(baseb + off0 + (size_t)(g8 * 16) * D + bj * 128);
            } }
#pragma unroll
        for (int gi = 0; gi < 8; ++gi) {
            const int ai = gi >> 2, m = gi & 3;
            const int row = u.pm * 256 + ai * 128 + wr * 64 + m * 16 + fr; const size_t off = (size_t)row * D + col0; float ss = 0.f;
            const float rl = MIDK ? rs2[ai * 128 + wr * 64 + m * 16 + fr].y : 1.0f;
            if constexpr (BF32) { if (gi < 7) { const int ai2 = (gi + 1) >> 2, m2 = (gi + 1) & 3; const size_t off2 = (size_t)(u.pm * 256 + ai2 * 128 + wr * 64 + m2 * 16 + fr) * D + col0;
#pragma unroll
                for (int bj = 0; bj < 2; ++bj) { pre[(gi + 1) & 1][bj][0] = *(const f32x4*)(basef + off2 + bj * 128); pre[(gi + 1) & 1][bj][1] = *(const f32x4*)(basef + off2 + bj * 128 + 4); } } }
#pragma unroll
            for (int bj = 0; bj < 2; ++bj) {
                f32x4 r0, r1;
                if constexpr (BF32) { r0 = pre[gi & 1][bj][0]; r1 = pre[gi & 1][bj][1]; }
                else { const u32x4 v = prb[gi & 3][bj]; r0 = (f32x4){__uint_as_float(v.x << 16), __uint_as_float(v.x & 0xffff0000u), __uint_as_float(v.y << 16), __uint_as_float(v.y & 0xffff0000u)};
                    r1 = (f32x4){__uint_as_float(v.z << 16), __uint_as_float(v.z & 0xffff0000u), __uint_as_float(v.w << 16), __uint_as_float(v.w & 0xffff0000u)};
                    if (gi < 4) prb[gi & 3][bj] = *(const u32x4*)(baseb + (size_t)(u.pm * 256 + 128 + wr * 64 + gi * 16 + fr) * D + col0 + bj * 128); }
                const f32x4 x0 = r0 + gv[bj][0] * (MIDK ? acc[ai][bj][m][0] * rl : acc[ai][bj][m][0]), x1 = r1 + gv[bj][1] * (MIDK ? acc[ai][bj][m][1] * rl : acc[ai][bj][m][1]);
                ss += ((x0[0] * x0[0] + x0[1] * x0[1]) + (x0[2] * x0[2] + x0[3] * x0[3])) + ((x1[0] * x1[0] + x1[1] * x1[1]) + (x1[2] * x1[2] + x1[3] * x1[3]));
                u32x4 w; w.x = cvt_pk_bf16(x0[0], x0[1]); w.y = cvt_pk_bf16(x0[2], x0[3]); w.z = cvt_pk_bf16(x1[0], x1[1]); w.w = cvt_pk_bf16(x1[2], x1[3]);
                *(u32x4*)(XB + off + bj * 128) = w;
                const f32x4 y0 = x0 * gs[bj][0], y1 = x1 * gs[bj][1];
                u32x4 wg; wg.x = cvt_pk_bf16(y0[0], y0[1]); wg.y = cvt_pk_bf16(y0[2], y0[3]); wg.z = cvt_pk_bf16(y1[0], y1[1]); wg.w = cvt_pk_bf16(y1[2], y1[3]);
                *(u32x4*)(XG + off + bj * 128) = wg; }
            ss += __shfl_xor(ss, 16); ss += __shfl_xor(ss, 32);
            if (fq == 0) rowss[(size_t)row * 16 + u.pn * 4 + wc] = ss;
            asm volatile("" ::: "memory");
        }
    }
};

constexpr int CW_PANEL = 9216;
struct EpiFinal {
    static constexpr bool PERM = false, MIDK = false, PRE = false, POST = false;
    struct PreRegs {};
    const bf16_t* base; float* out; unsigned char* ws; int goff; const float* fg;
    __device__ __forceinline__ void operator()(f32x4 (&acc)[2][2][4][2], const pg8::Unit& u, int wr, int wc, int fr, int fq, LAS unsigned char* ldsx, int wid, int lane, int, int) const {
        asm volatile("" : "+v"(fr), "+v"(fq), "+v"(lane));
        const float* gate = (const float*)(ws + WS_MOD) + goff; float* rowss = (float*)(ws + WS_ROWSS); unsigned* pcnt = (unsigned*)(ws + WS_CTL) + CW_PANEL + 64 * u.pm;
        const int b = u.pm >> 3, col0 = u.pn * 256 + wc * 32 + 4 * fq;
        {   f32x4 gv[2][2];
#pragma unroll
            for (int bj = 0; bj < 2; ++bj)
#pragma unroll
                for (int n = 0; n < 2; ++n) gv[bj][n] = *(const f32x4*)(gate + (size_t)b * 6144 + col0 + bj * 128 + n * 16);
            u32x2 pre[2][2][2];
#pragma unroll
            for (int bj = 0; bj < 2; ++bj)
#pragma unroll
                for (int n = 0; n < 2; ++n) pre[0][bj][n] = *(const u32x2*)(base + (size_t)(u.pm * 256 + wr * 64 + fr) * D + col0 + bj * 128 + n * 16);
#pragma unroll
            for (int gi = 0; gi < 8; ++gi) {
                const int ai = gi >> 2, m = gi & 3; const int row = u.pm * 256 + ai * 128 + wr * 64 + m * 16 + fr; float ss = 0.f;
                if (gi < 7) { const int ai2 = (gi + 1) >> 2, m2 = (gi + 1) & 3; const size_t off2 = (size_t)(u.pm * 256 + ai2 * 128 + wr * 64 + m2 * 16 + fr) * D + col0;
#pragma unroll
                    for (int bj = 0; bj < 2; ++bj)
#pragma unroll
                        for (int n = 0; n < 2; ++n) pre[(gi + 1) & 1][bj][n] = *(const u32x2*)(base + off2 + bj * 128 + n * 16); }
#pragma unroll
                for (int bj = 0; bj < 2; ++bj)
#pragma unroll
                    for (int n = 0; n < 2; ++n) { const u32x2 v = pre[gi & 1][bj][n]; const f32x4 r = (f32x4){__uint_as_float(v.x << 16), __uint_as_float(v.x & 0xffff0000u), __uint_as_float(v.y << 16), __uint_as_float(v.y & 0xffff0000u)};
                        const f32x4 x = r + gv[bj][n] * acc[ai][bj][m][n]; acc[ai][bj][m][n] = x; ss += (x[0] * x[0] + x[1] * x[1]) + (x[2] * x[2] + x[3] * x[3]); }
                ss += __shfl_xor(ss, 16); ss += __shfl_xor(ss, 32);
                if (fq == 0) rowss[(size_t)row * 16 + u.pn * 4 + wc] = ss;
                asm volatile("" ::: "memory");
            }
        }
        asm volatile("s_waitcnt vmcnt(0)" ::: "memory"); __builtin_amdgcn_s_barrier(); asm volatile("" ::: "memory");
        if (wid == 0 && lane == 0) {
            const unsigned gm_ = group_mode(ws, (volatile LAS unsigned*)(ldsx + HALO_BYTES + 232));
            group_release(gm_);
            __hip_atomic_fetch_add(pcnt, 1u, __ATOMIC_RELAXED, __HIP_MEMORY_SCOPE_AGENT);
            unsigned sp = 0; while (__hip_atomic_load(pcnt, __ATOMIC_RELAXED, __HIP_MEMORY_SCOPE_AGENT) < 4u) { __builtin_amdgcn_s_sleep(1); if (++sp > (1u << 22)) break; }
            group_acquire(gm_); }
        __builtin_amdgcn_s_barrier(); asm volatile("" ::: "memory");
        const LAS float* rtab = rstd_table(rowss, u.pm, ldsx, wid, lane);
        f32x4 fgv[2][2];
#pragma unroll
        for (int bj = 0; bj < 2; ++bj)
#pragma unroll
            for (int n = 0; n < 2; ++n) fgv[bj][n] = *(const f32x4*)(fg + col0 + bj * 128 + n * 16);
#pragma unroll
        for (int ai = 0; ai < 2; ++ai)
#pragma unroll
            for (int m = 0; m < 4; ++m) { const int rl_ = ai * 128 + wr * 64 + m * 16 + fr; const float rs = rtab[rl_]; const size_t off = (size_t)(u.pm * 256 + rl_) * D + col0;
#pragma unroll
                for (int bj = 0; bj < 2; ++bj)
#pragma unroll
                    for (int n = 0; n < 2; ++n) { const f32x4 y = acc[ai][bj][m][n] * rs * fgv[bj][n]; st16_wt(out + off + bj * 128 + n * 16, __builtin_bit_cast(u32x4, y)); } }
    }
};

struct EpiGU {
    static constexpr bool PERM = true, MIDK = false, PRE = true, POST = false;
    unsigned char* ws; int l;
    typedef RstdAhead PreRegs;
    __device__ __forceinline__ void pre_issue(PreRegs& r, int pm, int wid, int lane) const { rstd_issue(r, (const float*)(ws + WS_ROWSS), pm, wid * 64 + lane); }
    __device__ __forceinline__ void pre_commit(const PreRegs& r, LAS unsigned char* ldsx, int wid, int lane) const { rstd_commit(r, (LAS float*)(ldsx + 4096), wid * 64 + lane); }
    static __device__ __forceinline__ float dpp_shr1(float old, float v) { return __int_as_float(__builtin_amdgcn_update_dpp(__float_as_int(old), __float_as_int(v), 0x111, 0xf, 0xf, false)); }
    static __device__ __forceinline__ float dpp_shr2(float old, float v) { return __int_as_float(__builtin_amdgcn_update_dpp(__float_as_int(old), __float_as_int(v), 0x112, 0xf, 0xf, false)); }
    static __device__ __forceinline__ float dpp_ror1(float v) { return __int_as_float(__builtin_amdgcn_update_dpp(0, __float_as_int(v), 0x121, 0xf, 0xf, true)); }
    static __device__ __forceinline__ float dpp_ror2(float v) { return __int_as_float(__builtin_amdgcn_update_dpp(0, __float_as_int(v), 0x122, 0xf, 0xf, true)); }
    __device__ __forceinline__ void operator()(f32x4 (&acc)[2][2][4][2], const pg8::Unit& u, int wr, int wc, int fr, int fq, LAS unsigned char* ldsx, int wid, int lane, int par, int nxt_pm) const {
        asm volatile("" : "+v"(fr), "+v"(fq), "+v"(lane)); asm volatile("" : "+s"(wr), "+s"(wc));
        RstdAhead ra; if (nxt_pm >= 0) rstd_issue(ra, (const float*)(ws + WS_ROWSS), nxt_pm, wid * 64 + lane);
        const float* shw = (const float*)(ws + WS_SHWG) + (size_t)l * NB * NGU; const float* cw = (const float*)(ws + WS_FCW) + (size_t)l * 4 * FF; const float* cb = cw + 3 * FF;
        bf16_t* ACT = (bf16_t*)(ws + WS_ACT); float* gfirst = (float*)(ws + WS_GFIRST); float* glast = (float*)(ws + WS_GLAST); float* ufirst = (float*)(ws + WS_UFIRST);
        const int b = u.pm >> 3, cin = wc * 32 + 8 * fq, colg = u.pn * 128 + cin;
        f32x4 bgv[2], buv[2], w0v[2], w1v[2], w2v[2], cbvv[2];
#pragma unroll
        for (int n = 0; n < 2; ++n) { bgv[n] = *(const f32x4*)(shw + (size_t)b * NGU + u.pn * 256 + cin + 4 * n); buv[n] = *(const f32x4*)(shw + (size_t)b * NGU + u.pn * 256 + 128 + cin + 4 * n);
            w0v[n] = *(const f32x4*)(cw + colg + 4 * n); w1v[n] = *(const f32x4*)(cw + FF + colg + 4 * n); w2v[n] = *(const f32x4*)(cw + 2 * FF + colg + 4 * n); cbvv[n] = *(const f32x4*)(cb + colg + 4 * n); }
        const LAS float* rtab = (const LAS float*)(ldsx + 4096 + 1024 * par);
        LAS float* halo = (LAS float*)ldsx;
#pragma unroll
        for (int ai = 0; ai < 2; ++ai)
#pragma unroll
            for (int m = 0; m < 4; ++m) { const float rs = rtab[ai * 128 + wr * 64 + m * 16 + fr];
#pragma unroll
                for (int n = 0; n < 2; ++n) { acc[ai][0][m][n] = acc[ai][0][m][n] * rs + bgv[n]; acc[ai][1][m][n] = acc[ai][1][m][n] * rs + buv[n]; }
                if (m == 3) { if (fr >= 14) {
#pragma unroll
                    for (int n = 0; n < 2; ++n) *(LAS f32x4*)(halo + ((ai * 2 + wr) * 2 + (fr - 14)) * 128 + cin + 4 * n) = acc[ai][0][3][n]; } } }
        LDS_WAIT(); __builtin_amdgcn_s_barrier(); asm volatile("" ::: "memory");
        const bool f0 = fr == 0, f01 = fr < 2;
#pragma unroll
        for (int ai = 0; ai < 2; ++ai)
#pragma unroll
            for (int m = 0; m < 4; ++m) {
                const size_t row = (size_t)u.pm * 256 + ai * 128 + wr * 64 + m * 16 + fr;
                u32x4 wout;
#pragma unroll
                for (int n = 0; n < 2; ++n) {
                    const f32x4 w0 = w0v[n], w1 = w1v[n], w2 = w2v[n], cbv = cbvv[n];
                    const f32x4 g0 = acc[ai][0][m][n]; f32x4 g1, g2;
                    if (m > 0) { const f32x4 P = acc[ai][0][m > 0 ? m - 1 : 0][n];
#pragma unroll
                        for (int j = 0; j < 4; ++j) { g1[j] = dpp_shr1(dpp_ror1(P[j]), g0[j]); g2[j] = dpp_shr2(dpp_ror2(P[j]), g0[j]); } }
                    else { const int slot = wr == 1 ? ai * 2 : (ai == 1 ? 1 : 0);
                        const f32x4 p14 = *(const LAS f32x4*)(halo + (slot * 2 + 0) * 128 + cin + 4 * n), p15 = *(const LAS f32x4*)(halo + (slot * 2 + 1) * 128 + cin + 4 * n);
#pragma unroll
                        for (int j = 0; j < 4; ++j) { g1[j] = dpp_shr1(p15[j], g0[j]); g2[j] = dpp_shr2(f0 ? p14[j] : p15[j], g0[j]); } }
                    const f32x4 cv = cbv + w0 * g2 + w1 * g1 + w2 * g0, up = acc[ai][1][m][n];
                    if (ai == 0 && m == 0) { if (wr == 0 && f01) { *(f32x4*)(gfirst + ((size_t)u.pm * 2 + fr) * FF + colg + 4 * n) = g0; *(f32x4*)(ufirst + ((size_t)u.pm * 2 + fr) * FF + colg + 4 * n) = up; } }
                    if (ai == 1 && m == 3) { if (wr == 1 && fr >= 14) *(f32x4*)(glast + ((size_t)u.pm * 2 + (fr - 14)) * FF + colg + 4 * n) = g0; }
                    const float r0 = siluf_(cv[0]) * up[0], r1 = siluf_(cv[1]) * up[1], r2 = siluf_(cv[2]) * up[2], r3 = siluf_(cv[3]) * up[3];
                    if (n == 0) { wout.x = cvt_pk_bf16(r0, r1); wout.y = cvt_pk_bf16(r2, r3); } else { wout.z = cvt_pk_bf16(r0, r1); wout.w = cvt_pk_bf16(r2, r3); }
                }
                if (ai == 0 && m == 0) { if (!(wr == 0 && f01)) st16_wt(ACT + row * FF + colg, wout); }
                else st16_wt(ACT + row * FF + colg, wout);
            }
        if (nxt_pm >= 0) rstd_commit(ra, (LAS float*)(ldsx + 4096 + 1024 * (par ^ 1)), wid * 64 + lane);
    }
};

#define XB_TMO      128
#define XB_XCNT(j)  (256  + 64 * (j))
#define XB_XSUB(j)  (1280 + 64 * (j))
#define XB_XGEN(j)  (2304 + 64 * (j))
#define XB_TOP      3328
#define XB_TOPGEN   3392
#define XCD_BAR_WORDS 3456
#define XB_SPIN_CAP (1u << 18)
__device__ __forceinline__ unsigned xb_ld(unsigned* p)              { return __hip_atomic_load(p, __ATOMIC_RELAXED, __HIP_MEMORY_SCOPE_AGENT); }
__device__ __forceinline__ unsigned xb_add(unsigned* p, unsigned v) { return __hip_atomic_fetch_add(p, v, __ATOMIC_RELAXED, __HIP_MEMORY_SCOPE_AGENT); }
__device__ __forceinline__ unsigned xb_xcc_id() { return (unsigned)__builtin_amdgcn_s_getreg((3 << 11) | 20) & 0xFu; }
#define XB_SPIN(cond, bar) do { unsigned _sp = 0; while (cond) { __builtin_amdgcn_s_sleep(1); \
    if ((++_sp & 255u) == 0u) { if (xb_ld(&(bar)[XB_TMO])) break; if (_sp > XB_SPIN_CAP) { atomicAdd(&(bar)[XB_TMO], 1u); break; } } } } while (0)
__device__ __forceinline__ void xcd_barrier_complete(unsigned* bar, unsigned x, unsigned& nloc, unsigned& nx) {
    const unsigned G = gridDim.x * gridDim.y * gridDim.z;
    unsigned sum, cnt, mine, sp = 0u;
    for (;;) {
        sum = 0u; cnt = 0u; mine = 0u;
#pragma unroll
        for (unsigned j = 0; j < 16; ++j) { const unsigned c = xb_ld(&bar[XB_XCNT(j)]); sum += c; cnt += (c > 0u) ? 1u : 0u; mine = (j == x) ? c : mine; }
        if (sum == G) break;
        __builtin_amdgcn_s_sleep(1);
        if ((++sp & 255u) == 0u) { if (xb_ld(&bar[XB_TMO])) break; if (sp > XB_SPIN_CAP) { atomicAdd(&bar[XB_TMO], 1u); break; } }
    }
    nloc = mine > 0u ? mine : 1u; nx = cnt > 0u ? cnt : 1u;
}
__device__ __forceinline__ void xcd_barrier(unsigned* bar, volatile LAS unsigned* st, int wave) {
    int l0_; asm volatile("v_mbcnt_lo_u32_b32 %0, -1, 0\n\tv_mbcnt_hi_u32_b32 %0, -1, %0" : "=v"(l0_)); const bool is_t0 = (wave == 0) && (l0_ == 0);
    asm volatile("s_waitcnt vmcnt(0)" ::: "memory");
    __syncthreads();
    if (is_t0) {
        __builtin_amdgcn_s_waitcnt(0);
        const unsigned x = xb_xcc_id();
        unsigned nloc = st[0], nx = st[1];
        if (nloc == 0u) { xcd_barrier_complete(bar, x, nloc, nx); st[0] = nloc; st[1] = nx; }
        const unsigned old = xb_add(&bar[XB_XSUB(x)], 1u);
        const unsigned gen = old / nloc;
        if (old + 1u == (gen + 1u) * nloc) {
            __builtin_amdgcn_fence(__ATOMIC_RELEASE, "agent");
            asm volatile("s_waitcnt vmcnt(0)" ::: "memory");
            const unsigned og = xb_add(&bar[XB_TOP], 1u);
            const unsigned tg = og / nx;
            if (og + 1u == (tg + 1u) * nx) xb_add(&bar[XB_TOPGEN], 1u);
            else XB_SPIN(xb_ld(&bar[XB_TOPGEN]) == tg, bar);
            __builtin_amdgcn_fence(__ATOMIC_ACQUIRE, "agent");
            xb_add(&bar[XB_XGEN(x)], 1u);
            asm volatile("s_waitcnt vmcnt(0)" ::: "memory");
        } else {
            XB_SPIN(xb_ld(&bar[XB_XGEN(x)]) == gen, bar);
            __builtin_amdgcn_fence(__ATOMIC_ACQUIRE, "agent");
            asm volatile("s_waitcnt vmcnt(0)" ::: "memory");
        }
    }
    __syncthreads();
}
__device__ __forceinline__ void group_arrive(unsigned char* ws, volatile LAS unsigned* gst, int wave) {
    int l0_; asm volatile("v_mbcnt_lo_u32_b32 %0, -1, 0\n\tv_mbcnt_hi_u32_b32 %0, -1, %0" : "=v"(l0_)); const bool is_t0 = (wave == 0) && (l0_ == 0);
    asm volatile("s_waitcnt vmcnt(0)" ::: "memory");
    __syncthreads();
    if (is_t0) {
        group_release(group_mode(ws, gst));
        unsigned* cnt = (unsigned*)(ws + WS_CTL) + CW_GROUPBAR + 64 * (blockIdx.x & 7);
        gst[1] = gst[1] + 1u;
        (void)xb_add(cnt, 1u);
    }
}
__device__ __forceinline__ void group_wait(unsigned char* ws, unsigned* bar, volatile LAS unsigned* gst, int wave) {
    int l0_; asm volatile("v_mbcnt_lo_u32_b32 %0, -1, 0\n\tv_mbcnt_hi_u32_b32 %0, -1, %0" : "=v"(l0_)); const bool is_t0 = (wave == 0) && (l0_ == 0);
    asm volatile("s_waitcnt vmcnt(0)" ::: "memory");
    __syncthreads();
    if (is_t0) {
        unsigned* cnt = (unsigned*)(ws + WS_CTL) + CW_GROUPBAR + 64 * (blockIdx.x & 7);
        const unsigned target = gst[1] * (gridDim.x >> 3);
        XB_SPIN(xb_ld(cnt) < target, bar);
        group_acquire(group_mode(ws, gst));
    }
    __syncthreads();
}
__device__ __forceinline__ void group_barrier(unsigned char* ws, unsigned* bar, volatile LAS unsigned* gst, int wave) { group_arrive(ws, gst, wave); group_wait(ws, bar, gst, wave); }

struct Args { const float* in[29]; float* out; unsigned char* ws; int ph_lo, ph_hi; };
struct Frame {
    LAS unsigned char* lds; int tid, lane, wave, G, bid;
    volatile LAS unsigned long long* inl; float* out; unsigned char* ws;
};
__device__ __forceinline__ const float* INP(const Frame& F, int k) { const unsigned long long v = F.inl[k]; const unsigned lo = __builtin_amdgcn_readfirstlane((unsigned)v), hi = __builtin_amdgcn_readfirstlane((unsigned)(v >> 32)); return (const float*)(((unsigned long long)hi << 32) | lo); }
#define IN_X 0
#define IN_C 1
#define IN_ADAW 2
#define IN_ADAB 3
#define IN_MIXG 4
#define IN_FFNG 5
#define IN_WIN 6
#define IN_GATEB 7
#define IN_CPOS 8
#define IN_CW1 9
#define IN_CB1 10
#define IN_CW2 11
#define IN_CB2 12
#define IN_LCW 13
#define IN_LCB 14
#define IN_LWA 15
#define IN_LBA 16
#define IN_LWX 17
#define IN_LBX 18
#define IN_LLAM 19
#define IN_NSAG 20
#define IN_LRUG 21
#define IN_WOUT 22
#define IN_WG 23
#define IN_WU 24
#define IN_FCW 25
#define IN_FCB 26
#define IN_WD 27
#define IN_FING 28

__device__ __forceinline__ void ph_mod(const Frame& F) {
    LAS float* cact = (LAS float*)F.lds;
    LAS float* part = cact + 8192;
    const float* c = INP(F, IN_C);
    for (int i = F.tid; i < NB * D; i += 512) { const float v = c[i]; cact[i] = siluf_(v); }
    __syncthreads();
    float* mod = (float*)(F.ws + WS_MOD);
    for (int item = F.bid; item < NL * 192; item += F.G) {
        const int l = item / 192, n0 = (item % 192) * 32, col = F.lane & 31, kp = F.lane >> 5;
        const float* w = INP(F, IN_ADAW) + (size_t)l * D * 6144 + n0 + col;
        float acc[8];
#pragma unroll
        for (int b = 0; b < 8; ++b) acc[b] = 0.f;
#pragma unroll 32
        for (int i = 0; i < 64; ++i) { const int k = F.wave * 128 + 2 * i + kp; const float wv = __builtin_nontemporal_load(w + (size_t)k * 6144);
#pragma unroll
            for (int b = 0; b < 8; ++b) acc[b] += cact[b * D + k] * wv; }
#pragma unroll
        for (int b = 0; b < 8; ++b) acc[b] += __shfl_xor(acc[b], 32);
        if (F.lane < 32) {
#pragma unroll
            for (int b = 0; b < 8; ++b) part[(F.wave * 8 + b) * 32 + col] = acc[b]; }
        __syncthreads();
        if (F.tid < 256) { const int b = F.tid >> 5, cc = F.tid & 31; float s = 0.f;
#pragma unroll
            for (int w8 = 0; w8 < 8; ++w8) s += part[(w8 * 8 + b) * 32 + cc];
            mod[(size_t)(l * NB + b) * 6144 + n0 + cc] = s + INP(F, IN_ADAB)[l * 6144 + n0 + cc]; }
        __syncthreads();
    }
}
template <class SRC> __device__ __forceinline__ void tr_tile(const SRC& src, int K, bf16_t* dst, int k0, int n0, LAS float* scr, int lane) {
    float tv[32];
#pragma unroll
    for (int i = 0; i < 32; ++i) tv[i] = src(k0 + 2 * i + (lane >> 5), n0 + (lane & 31));
#pragma unroll
    for (int i = 0; i < 32; ++i) scr[(2 * i + (lane >> 5)) * 33 + (lane & 31)] = tv[i];
    LDS_WAIT(); asm volatile("" ::: "memory");
    const int c = lane & 7;
#pragma unroll
    for (int j = 0; j < 4; ++j) { const int n = (lane >> 3) + 8 * j; const LAS float* s = scr + (8 * c) * 33 + n;
        u32x4 o; o.x = cvt_pk_bf16(s[0 * 33], s[1 * 33]); o.y = cvt_pk_bf16(s[2 * 33], s[3 * 33]); o.z = cvt_pk_bf16(s[4 * 33], s[5 * 33]); o.w = cvt_pk_bf16(s[6 * 33], s[7 * 33]);
        *(u32x4*)(dst + (size_t)(n0 + n) * K + k0 + 8 * c) = o; }
    LDS_WAIT(); asm volatile("" ::: "memory");
}
__device__ __forceinline__ void ph_posp(const Frame& F) {
    LAS float* red = (LAS float*)F.lds;
    for (int vb = F.bid; vb < NL * 2 * 32; vb += F.G) { const int lk = vb >> 5, sl = vb & 31, n = F.tid & 255, kh = F.tid >> 8;
        const float* W = INP(F, IN_CW1) + (size_t)lk * 2048 * 256 + (size_t)(sl * 64 + kh * 32) * 256 + n; const float* pos = INP(F, IN_CPOS) + (size_t)lk * 2048 + sl * 64 + kh * 32;
        float sacc = 0.f;
#pragma unroll
        for (int k = 0; k < 32; ++k) sacc += pos[k] * W[(size_t)k * 256];
        __syncthreads();
        if (kh) red[n] = sacc;
        __syncthreads();
        if (!kh) ((float*)(F.ws + WS_POSP))[((size_t)lk * 32 + sl) * 256 + n] = sacc + red[n]; }
}
__device__ __forceinline__ void ph_convert(const Frame& F) {
    LAS float* scr = (LAS float*)(F.lds + 40960 + F.wave * 8704);
    const int gw = F.bid * 8 + F.wave, NGW = F.G * 8;
    constexpr int I_WIN = 16 * 80, I_WOUT = 16 * 32, I_WGU = 16 * 176, I_WDN = 44 * 32, I_CW1 = 2 * 32 * 8, I_CW2 = 2 * 4 * 2, I_LRU = 8 * 4, I_L = I_WIN + I_WOUT + I_WGU + I_WDN + I_CW1 + I_CW2 + I_LRU;
    for (int it = gw; it < NL * I_L; it += NGW) {
        const int l = it / I_L; int r = it % I_L;
        unsigned char* wl = F.ws + WS_WTS + (size_t)l * WTS_LAYER;
        if (r < I_WIN) { const float* W = INP(F, IN_WIN) + (size_t)l * D * NINSRC;
            auto src = [=](int k, int n) -> float { return n < 1280 ? __builtin_nontemporal_load(W + (size_t)k * NINSRC + n) : n < 2304 ? __builtin_nontemporal_load(W + (size_t)k * NINSRC + n + 24) : n < 2328 ? __builtin_nontemporal_load(W + (size_t)k * NINSRC + n - 1024) : 0.f; };
            tr_tile(src, D, (bf16_t*)(wl + WO_WIN), (r / 80) * 64, (r % 80) * 32, scr, F.lane); continue; } r -= I_WIN;
        if (r < I_WOUT) { const float* W = INP(F, IN_WOUT) + (size_t)l * D * D; const float* g1 = INP(F, IN_NSAG) + l * 512; const float* g2 = INP(F, IN_LRUG) + l * 512;
            auto src = [=](int k, int n) -> float { return __builtin_nontemporal_load(W + (size_t)k * D + n) * (k < 512 ? g1[k] : g2[k - 512]); };
            tr_tile(src, D, (bf16_t*)(wl + WO_WOUT), (r / 32) * 64, (r % 32) * 32, scr, F.lane); continue; } r -= I_WOUT;
        if (r < I_WGU) { const float* Wg = INP(F, IN_WG) + (size_t)l * D * FF; const float* Wu = INP(F, IN_WU) + (size_t)l * D * FF;
            auto src = [=](int k, int n) -> float { const int un = n >> 8, w = n & 255; return w < 128 ? __builtin_nontemporal_load(Wg + (size_t)k * FF + un * 128 + w) : __builtin_nontemporal_load(Wu + (size_t)k * FF + un * 128 + w - 128); };
            tr_tile(src, D, (bf16_t*)(wl + WO_WGU), (r / 176) * 64, (r % 176) * 32, scr, F.lane); continue; } r -= I_WGU;
        if (r < I_WDN) { const float* W = INP(F, IN_WD) + (size_t)l * FF * D;
            auto src = [=](int k, int n) -> float { return __builtin_nontemporal_load(W + (size_t)k * D + n); };
            tr_tile(src, FF, (bf16_t*)(wl + WO_WDN), (r / 32) * 64, (r % 32) * 32, scr, F.lane); continue; } r -= I_WDN;
        if (r < I_CW1) { const int kv = r / 256, rr = r % 256, nt = rr >> 5, ksb = (rr & 31) * 4; const float* W = INP(F, IN_CW1) + (size_t)(l * 2 + kv) * 2048 * 256;
            bf16_t* dst = (bf16_t*)(wl + WO_CW1) + (((size_t)(kv * 8 + nt) * 128 + ksb) * 64 + F.lane) * 8;
#pragma unroll
            for (int q = 0; q < 4; ++q) { const int k0 = 16 * (ksb + q) + 8 * (F.lane >> 5), nn = 32 * nt + (F.lane & 31); float v[8];
#pragma unroll
                for (int j = 0; j < 8; ++j) v[j] = W[(size_t)(k0 + j) * 256 + nn];
                u32x4 o; o.x = pk2(v[0], v[1]); o.y = pk2(v[2], v[3]); o.z = pk2(v[4], v[5]); o.w = pk2(v[6], v[7]); *(u32x4*)(dst + (size_t)q * 512) = o; }
            continue; } r -= I_CW1;
        if (r < I_CW2) { const int kv = r / 8, rr = r % 8; const float* W = INP(F, IN_CW2) + (size_t)(l * 2 + kv) * 256 * 64;
            auto src = [=](int k, int n) -> float { return W[(size_t)k * 64 + n]; };
            tr_tile(src, 256, (bf16_t*)(wl + WO_CW2) + (size_t)kv * 64 * 256, (rr / 2) * 64, (rr % 2) * 32, scr, F.lane); continue; } r -= I_CW2;
        { const int blk = r / 4, nb = r % 4; const float* Wa = INP(F, IN_LWA) + (size_t)(l * 8 + blk) * 4096; const float* Wx = INP(F, IN_LWX) + (size_t)(l * 8 + blk) * 4096;
            auto src = [=](int k, int n) -> float { return n < 64 ? Wa[k * 64 + n] : Wx[k * 64 + n - 64]; };
            tr_tile(src, 64, (bf16_t*)(wl + WO_LRUW) + (size_t)blk * 128 * 64, 0, nb * 32, scr, F.lane); }
    }
}

__device__ __forceinline__ void ph_prep(const Frame& F) {
    const float* mod = (const float*)(F.ws + WS_MOD);
    for (int vb = F.bid; vb < 256; vb += F.G) {
        const int l = vb >> 6, sub = vb & 63; const bool isg = sub >= 20; const int rbase = (isg ? sub - 20 : sub) * 128;
        constexpr int SHS = 2112;
        LAS unsigned char* shl = F.lds;
        __syncthreads();
        for (int i = F.tid; i < NB * D / 2; i += 512) { const int b = i >> 9, k = (i & 511) * 2;
            const f32x2 v = *(const f32x2*)(mod + (size_t)(l * NB + b) * 6144 + (isg ? 3072 : 0) + k);
            const unsigned h0 = f2bf(v.x), h1 = f2bf(v.y);
            *(LAS unsigned*)(shl + b * SHS + k * 2) = h0 | (h1 << 16);
            *(LAS unsigned*)(shl + (8 + b) * SHS + k * 2) = pk2(v.x - bf2f(h0), v.y - bf2f(h1)); }
        __syncthreads();
        const bf16_t* Wt = (const bf16_t*)(F.ws + WS_WTS + (size_t)l * WTS_LAYER + (isg ? WO_WGU : WO_WIN));
        float* dst = (float*)(F.ws + (isg ? WS_SHWG : WS_SHW1)) + (size_t)l * NB * (isg ? NGU : NIN); const int ldn = isg ? NGU : NIN;
        const int n0 = rbase + F.wave * 16, fr = F.lane & 15, fq = F.lane >> 4;
        const bf16_t* wp = Wt + (size_t)(n0 + fr) * D + 8 * fq;
        const LAS unsigned char* bp = shl + (fr & 7) * SHS + 16 * fq;
        f32x4 acc = {0.f, 0.f, 0.f, 0.f};
#pragma unroll
        for (int h = 0; h < 2; ++h) {
            bf16x8 af[16];
#pragma unroll
            for (int q = 0; q < 16; ++q) af[q] = *(const bf16x8*)(wp + (h * 16 + q) * 32);
#pragma unroll
            for (int q = 0; q < 16; ++q) { const int ko = (h * 16 + q) * 64;
                const bf16x8 bh = *(const LAS bf16x8*)(bp + ko), bl = *(const LAS bf16x8*)(bp + 8 * SHS + ko);
                acc = __builtin_amdgcn_mfma_f32_16x16x32_bf16(af[q], bh, acc, 0, 0, 0); acc = __builtin_amdgcn_mfma_f32_16x16x32_bf16(af[q], bl, acc, 0, 0, 0); }
        }
        if (fr < 8) *(f32x4*)(dst + (size_t)fr * ldn + n0 + 4 * fq) = acc;
    }
    __syncthreads();
    {   float* posb = (float*)(F.ws + WS_POSB); const float* posp = (const float*)(F.ws + WS_POSP);
        for (int i = F.bid * 512 + F.tid; i < NL * 2 * 256; i += F.G * 512) { const int n = i & 255, lk = i >> 8; float sacc = INP(F, IN_CB1)[lk * 256 + n];
#pragma unroll
            for (int sl = 0; sl < 32; ++sl) sacc += posp[((size_t)lk * 32 + sl) * 256 + n];
            posb[i] = sacc; }
    }
    {   float* fcw = (float*)(F.ws + WS_FCW);
        for (int i = F.bid * 512 + F.tid; i < NL * 4 * FF; i += F.G * 512) { const int col = i % FF, k = (i / FF) & 3, l = i / (4 * FF); fcw[i] = k < 3 ? INP(F, IN_FCW)[(size_t)(l * 3 + k) * FF + col] : INP(F, IN_FCB)[(size_t)l * FF + col]; }
    }
    {
        float* gs = (float*)(F.ws + WS_GS);
        for (int i = F.bid * 512 + F.tid; i < NL * 2 * NB * D; i += F.G * 512) { const int col = i & 1023, b = (i >> 10) & 7, w = (i >> 13) & 1, l = i >> 14;
            gs[i] = INP(F, w ? IN_FFNG : IN_MIXG)[l * D + col] * (1.0f + mod[(size_t)(l * NB + b) * 6144 + (w ? 4096 : 1024) + col]); }
    }
    {
        const float* x = INP(F, IN_X); bf16_t* XG = (bf16_t*)(F.ws + WS_XG); float* rowss = (float*)(F.ws + WS_ROWSS); const float* mg = INP(F, IN_MIXG);
        for (int rw = (F.bid * 8 + F.wave) * 8; rw < T; rw += F.G * 64) { const int b = rw >> 11; f32x4 gm[4], v[4];
#pragma unroll
            for (int j = 0; j < 4; ++j) { const int col = j * 256 + F.lane * 4; v[j] = __builtin_nontemporal_load((const f32x4*)(x + (size_t)rw * D + col));
                gm[j] = *(const f32x4*)(mg + col) * (*(const f32x4*)(mod + (size_t)b * 6144 + 1024 + col) + 1.0f); }
#pragma unroll 1
            for (int i = 0; i < 8; ++i) { const int row = rw + i, rn = i < 7 ? row + 1 : row; f32x4 nv[4]; float ss = 0.f;
#pragma unroll
                for (int j = 0; j < 4; ++j) nv[j] = __builtin_nontemporal_load((const f32x4*)(x + (size_t)rn * D + j * 256 + F.lane * 4));
#pragma unroll
                for (int j = 0; j < 4; ++j) { const int col = j * 256 + F.lane * 4; ss += (v[j][0] * v[j][0] + v[j][1] * v[j][1]) + (v[j][2] * v[j][2] + v[j][3] * v[j][3]);
                    const f32x4 y = v[j] * gm[j]; u32x2 w; w.x = pk2(y[0], y[1]); w.y = pk2(y[2], y[3]); *(u32x2*)(XG + (size_t)row * D + col) = w; }
                ss = wave_sum(ss);
                if (F.lane < 16) rowss[(size_t)row * 16 + F.lane] = F.lane == 0 ? ss : 0.f;
#pragma unroll
                for (int j = 0; j < 4; ++j) v[j] = nv[j]; } }
    }
}

namespace at {
typedef float f32x16 __attribute__((ext_vector_type(16)));
typedef short v4i16_t __attribute__((ext_vector_type(4)));
constexpr int BUF = 16384;
__device__ __forceinline__ int crow(int r, int hi) { return (r & 3) + 8 * (r >> 2) + 4 * hi; }
struct Stg { u32x4 k, v; };
__device__ __forceinline__ void stage_load(Stg& s, const bf16_t* Kg, const bf16_t* Vg, int key0, int wid, int lane) {
    s.k = *(const u32x4*)(Kg + (size_t)(key0 + lane) * 64 + wid * 8);
    s.v = *(const u32x4*)(Vg + (size_t)(key0 + 16 * (wid & 3) + (lane >> 2)) * 64 + (wid >> 2) * 32 + (lane & 3) * 8);
}
__device__ __forceinline__ void stage_write(const Stg& s, LAS unsigned char* buf, int wid, int lane) {
    *(LAS u32x4*)(buf + wid * 1024 + lane * 16) = s.k;
    *(LAS u32x4*)(buf + 8192 + wid * 1024 + lane * 16) = s.v;
}
__device__ __forceinline__ void qkt(f32x16& p0, f32x16& p1, const LAS unsigned char* buf, const bf16x8 (&qr)[4], int r32, int hi) {
    const LAS unsigned char* kb = buf + hi * 1024 + r32 * 16;
    bf16x8 b0[4], b1[4];
#pragma unroll
    for (int d0 = 0; d0 < 4; ++d0) { b0[d0] = *(const LAS bf16x8*)(kb + d0 * 2048); b1[d0] = *(const LAS bf16x8*)(kb + d0 * 2048 + 512); }
    asm volatile("s_waitcnt lgkmcnt(0)" ::: "memory");
#pragma unroll
    for (int d0 = 0; d0 < 4; ++d0) { p0 = __builtin_amdgcn_mfma_f32_32x32x16_bf16(b0[d0], qr[d0], p0, 0, 0, 0); p1 = __builtin_amdgcn_mfma_f32_32x32x16_bf16(b1[d0], qr[d0], p1, 0, 0, 0); }
}
__device__ __forceinline__ bf16x8 vfrag(const LAS unsigned char* p) {
    const v4i16_t lo = __builtin_amdgcn_ds_read_tr16_b64_v4i16((LAS v4i16_t*)p), hi = __builtin_amdgcn_ds_read_tr16_b64_v4i16((LAS v4i16_t*)(p + 512));
    return (bf16x8){lo[0], lo[1], lo[2], lo[3], hi[0], hi[1], hi[2], hi[3]};
}
__device__ __forceinline__ bf16x8 pack8(const f32x16& p, int base) {
    u32x4 w; w.x = cvt_pk_bf16(p[base], p[base + 1]); w.y = cvt_pk_bf16(p[base + 2], p[base + 3]); w.z = cvt_pk_bf16(p[base + 4], p[base + 5]); w.w = cvt_pk_bf16(p[base + 6], p[base + 7]);
    return __builtin_bit_cast(bf16x8, w);
}
__device__ __forceinline__ void pv(f32x16 (&o)[2], const LAS unsigned char* buf, const f32x16& p0, const f32x16& p1, int lane, int hi) {
    const LAS unsigned char* vb = buf + 8192 + ((lane >> 4) & 1) * 32 + (lane & 3) * 8 + (4 * hi + ((lane & 15) >> 2)) * 64;
    const bf16x8 P0 = pack8(p0, 0), P1 = pack8(p0, 8), P2 = pack8(p1, 0), P3 = pack8(p1, 8);
#pragma unroll
    for (int d0 = 0; d0 < 2; ++d0) {
        o[d0] = __builtin_amdgcn_mfma_f32_32x32x16_bf16(vfrag(vb + d0 * 4096), P0, o[d0], 0, 0, 0);
        o[d0] = __builtin_amdgcn_mfma_f32_32x32x16_bf16(vfrag(vb + d0 * 4096 + 1024), P1, o[d0], 0, 0, 0);
        o[d0] = __builtin_amdgcn_mfma_f32_32x32x16_bf16(vfrag(vb + d0 * 4096 + 2048), P2, o[d0], 0, 0, 0);
        o[d0] = __builtin_amdgcn_mfma_f32_32x32x16_bf16(vfrag(vb + d0 * 4096 + 3072), P3, o[d0], 0, 0, 0); }
}
__device__ __forceinline__ float xhalf(float v) { return __shfl_xor(v, 32); }
__device__ __forceinline__ float max3f(float a, float b, float c) { float r; asm("v_max3_f32 %0, %1, %2, %3" : "=v"(r) : "v"(a), "v"(b), "v"(c)); return r; }
__device__ __forceinline__ float rowmax32(f32x16& p0, f32x16& p1) {
    asm volatile("s_nop 15\n\ts_nop 7" : "+v"(p0), "+v"(p1));
    float a = max3f(p0[0], p0[1], p1[0]), b = max3f(p0[2], p0[3], p1[1]); a = max3f(a, p1[2], p1[3]);
#pragma unroll
    for (int r = 4; r < 16; r += 4) { a = max3f(a, p0[r], p0[r + 1]); b = max3f(b, p0[r + 2], p0[r + 3]); a = max3f(a, p1[r], p1[r + 1]); b = max3f(b, p1[r + 2], p1[r + 3]); }
    a = max3f(a, b, b);
    return max3f(a, xhalf(a), a);
}
constexpr float MASKED = -1.0e6f;
__device__ __forceinline__ void softmax_step(f32x16& p0, f32x16& p1, float& m, float& l, f32x16 (&o)[2], f32x16& negm) {
    const float rm = rowmax32(p0, p1);
    if (__any(rm > 0.f)) { const float dl = fmaxf(rm, 0.f), f = __builtin_amdgcn_exp2f(-dl); m += dl; l *= f;
#pragma unroll
        for (int r = 0; r < 16; ++r) { p0[r] -= dl; p1[r] -= dl; o[0][r] *= f; o[1][r] *= f; negm[r] = -m; } }
    float s = 0.f;
#pragma unroll
    for (int r = 0; r < 16; ++r) { p0[r] = __builtin_amdgcn_exp2f(p0[r]); p1[r] = __builtin_amdgcn_exp2f(p1[r]); s += p0[r] + p1[r]; }
    l += s;
}
__device__ __forceinline__ void partial_sm(f32x16& p0, f32x16& p1, float& m, float& l, f32x16 (&o)[2]) {
    const float rm = rowmax32(p0, p1);
    if (__any(rm > 0.f)) { const float dl = fmaxf(rm, 0.f), f = __builtin_amdgcn_exp2f(-dl); m += dl; l *= f;
#pragma unroll
        for (int r = 0; r < 16; ++r) { p0[r] -= dl; p1[r] -= dl; o[0][r] *= f; o[1][r] *= f; } }
}
__device__ __forceinline__ void finish_sm(f32x16& p0, f32x16& p1, float& l, bf16x8 (&pa)[4]) {
    float s = 0.f;
#pragma unroll
    for (int r = 0; r < 16; ++r) { p0[r] = __builtin_amdgcn_exp2f(p0[r]); p1[r] = __builtin_amdgcn_exp2f(p1[r]); s += p0[r] + p1[r]; }
    l += s;
    pa[0] = pack8(p0, 0); pa[1] = pack8(p0, 8); pa[2] = pack8(p1, 0); pa[3] = pack8(p1, 8);
}
__device__ __forceinline__ void pv_pk(f32x16 (&o)[2], const LAS unsigned char* buf, const bf16x8 (&pa)[4], int lane, int hi) {
    const LAS unsigned char* vb = buf + 8192 + ((lane >> 4) & 1) * 32 + (lane & 3) * 8 + (4 * hi + ((lane & 15) >> 2)) * 64;
    bf16x8 vf[2][4];
#pragma unroll
    for (int d0 = 0; d0 < 2; ++d0)
#pragma unroll
        for (int k4 = 0; k4 < 4; ++k4) vf[d0][k4] = vfrag(vb + d0 * 4096 + k4 * 1024);
    asm volatile("s_waitcnt lgkmcnt(0)" ::: "memory");
#pragma unroll
    for (int d0 = 0; d0 < 2; ++d0) {
        o[d0] = __builtin_amdgcn_mfma_f32_32x32x16_bf16(vf[d0][0], pa[0], o[d0], 0, 0, 0);
        o[d0] = __builtin_amdgcn_mfma_f32_32x32x16_bf16(vf[d0][1], pa[1], o[d0], 0, 0, 0);
        o[d0] = __builtin_amdgcn_mfma_f32_32x32x16_bf16(vf[d0][2], pa[2], o[d0], 0, 0, 0);
        o[d0] = __builtin_amdgcn_mfma_f32_32x32x16_bf16(vf[d0][3], pa[3], o[d0], 0, 0, 0); }
}
template <bool SEL> __device__ __forceinline__ void score_tile(f32x16& p0, f32x16& p1, const LAS unsigned char* stg, int tile, int qb, unsigned mask, const bf16x8 (&qr)[4], int tq, int r32, int hi, float m) {
    float c0 = -m; if constexpr (SEL) { const bool selb = (mask >> tile) & 1u; c0 = selb ? c0 : MASKED; }
#pragma unroll
    for (int r = 0; r < 16; ++r) { p0[r] = c0; p1[r] = c0; }
    qkt(p0, p1, stg, qr, r32, hi);
}
template <bool SEL> __device__ __forceinline__ void bound_mask(f32x16& p0, f32x16& p1, int tile, int qb, int tq, int hi) {
    if (tile == qb || (!SEL && tile + 8 == qb)) {
        const bool cz = tile == qb; const int lim = tq - 4 * hi;
#pragma unroll
        for (int r = 0; r < 16; ++r) { const int c0 = (r & 3) + 8 * (r >> 2), c1 = c0 + 32;
            const bool v0 = cz ? (c0 <= lim) : (c0 > lim), v1 = cz ? (c1 <= lim) : (c1 > lim);
            p0[r] = v0 ? p0[r] : MASKED; p1[r] = v1 ? p1[r] : MASKED; } }
}
__device__ __forceinline__ void glds16(const void* gsrc, unsigned lds_dst) { unsigned keep;
    asm volatile("s_mov_b32 %0, m0\n\ts_mov_b32 m0, %2\n\ts_nop 0\n\tglobal_load_lds_dwordx4 %1, off\n\ts_mov_b32 m0, %0" : "=&s"(keep) : "v"(gsrc), "s"(lds_dst) : "memory"); }
#define AT_WAIT_BAR(N) asm volatile("s_waitcnt vmcnt(" #N ") lgkmcnt(0)\n\ts_barrier" ::: "memory")
typedef short s16x4_t __attribute__((ext_vector_type(4)));
__device__ __forceinline__ s16x4_t vtr(const LAS unsigned char* p) { return __builtin_amdgcn_ds_read_tr16_b64_v4i16((LAS v4i16_t*)p); }
__device__ __forceinline__ unsigned cvtpk_s(float lo, float hi) { typedef float f2_t __attribute__((ext_vector_type(2))); typedef __bf16 b2_t __attribute__((ext_vector_type(2))); const f2_t v = {lo, hi}; const b2_t b = __builtin_convertvector(v, b2_t); return __builtin_bit_cast(unsigned, b); }
__device__ __forceinline__ void tile_dma_issue(const bf16_t* Kg, const bf16_t* Vg, int t_lo, int nt, LAS unsigned char* lds, int wid, int lane) {
    const unsigned lds0 = (unsigned)(unsigned long long)lds;
    const bf16_t* ksrc = Kg + (size_t)lane * 64 + wid * 8; const bf16_t* vsrc = Vg + (size_t)(16 * (wid & 3) + (lane >> 2)) * 64 + (wid >> 2) * 32 + (lane & 3) * 8;
    const unsigned kdst = lds0 + wid * 1024, vdst = lds0 + 3 * 8192 + wid * 1024;
    glds16(ksrc + (size_t)t_lo * 4096, (unsigned)__builtin_amdgcn_readfirstlane(kdst)); glds16(vsrc + (size_t)t_lo * 4096, (unsigned)__builtin_amdgcn_readfirstlane(vdst));
    glds16(ksrc + (size_t)(t_lo + (1 < nt ? 1 : nt - 1)) * 4096, (unsigned)__builtin_amdgcn_readfirstlane(kdst + 8192)); glds16(ksrc + (size_t)(t_lo + (2 < nt ? 2 : nt - 1)) * 4096, (unsigned)__builtin_amdgcn_readfirstlane(kdst + 2 * 8192));
}
template <bool SEL> __device__ __forceinline__ void tile_dma(f32x16 (&o)[2], float& lsum, const bf16_t* Kg, const bf16_t* Vg, int t_lo, int nt, int qb, unsigned mask, const bf16x8 (&qr)[4],
                                                            LAS unsigned char* lds, int tq, int wid, int lane, int r32, int hi) {
    constexpr int SLOTB = 8192, VOFF = 3 * SLOTB;
    const unsigned lds0 = (unsigned)(unsigned long long)lds;
    const bf16_t* ksrc = Kg + (size_t)lane * 64 + wid * 8;
    const bf16_t* vsrc = Vg + (size_t)(16 * (wid & 3) + (lane >> 2)) * 64 + (wid >> 2) * 32 + (lane & 3) * 8;
    const unsigned kdst = lds0 + wid * 1024, vdst = lds0 + VOFF + wid * 1024;
#define DMA_K(t, slot) glds16(ksrc + (size_t)(t_lo + ((t) < nt ? (t) : nt - 1)) * 4096, (unsigned)__builtin_amdgcn_readfirstlane(kdst + (slot)))
#define DMA_V(t, slot) glds16(vsrc + (size_t)(t_lo + ((t) < nt ? (t) : nt - 1)) * 4096, (unsigned)__builtin_amdgcn_readfirstlane(vdst + (slot)))
    const LAS unsigned char* kp0 = lds + hi * 1024 + r32 * 16;
    const LAS unsigned char* vp0 = lds + VOFF + ((lane >> 4) & 1) * 32 + (lane & 3) * 8 + (4 * hi + ((lane & 15) >> 2)) * 64;
    bf16x8 kf[8];
    float m = 0.f, l_reg = 0.f, fres = 1.f; bool resc = false;
#pragma unroll
    for (int r = 0; r < 16; ++r) { o[0][r] = 0.f; o[1][r] = 0.f; }
    f32x16 pA0, pA1, pB0, pB1;
    int sl_prev = 0, sl_cur = 0, sl_next = SLOTB;
#define ROT() do { sl_prev = sl_cur; sl_cur = sl_next; sl_next = (sl_next == 2 * SLOTB) ? 0 : sl_next + SLOTB; } while (0)
#define SBAR() __builtin_amdgcn_sched_barrier(0)
#define MX3(a, b, c) __builtin_fmaxf(__builtin_fmaxf((a), (b)), (c))
#define CINIT(C0, C1, tl) do { float c0_ = -m; if constexpr (SEL) { const bool sb_ = (mask >> (tl)) & 1u; c0_ = sb_ ? c0_ : MASKED; } _Pragma("unroll") for (int r = 0; r < 16; ++r) { C0[r] = c0_; C1[r] = c0_; } } while (0)
#define DECIDE(C0, C1, tl) do { \
        if ((tl) == qb || (!SEL && (tl) + 8 == qb)) bound_mask<SEL>(C0, C1, (tl), qb, tq, hi); \
        float a_ = MX3(C0[0], C0[1], C1[0]), b_ = MX3(C0[2], C0[3], C1[1]); a_ = MX3(a_, C1[2], C1[3]); \
        _Pragma("unroll") for (int r = 4; r < 16; r += 4) { a_ = MX3(a_, C0[r], C0[r + 1]); b_ = MX3(b_, C0[r + 2], C0[r + 3]); a_ = MX3(a_, C1[r], C1[r + 1]); b_ = MX3(b_, C1[r + 2], C1[r + 3]); } \
        float rm_ = __builtin_fmaxf(a_, b_); rm_ = __builtin_fmaxf(rm_, xhalf(rm_)); \
        resc = false; \
        if (__any(rm_ > 8.f)) { const float dl_ = __builtin_fmaxf(rm_, 0.f); m += dl_; \
            _Pragma("unroll") for (int r = 0; r < 16; ++r) { C0[r] -= dl_; C1[r] -= dl_; } \
            fres = __builtin_amdgcn_exp2f(-dl_); l_reg *= fres; resc = true; } } while (0)
#define RESC() do { if (resc) { _Pragma("unroll") for (int r = 0; r < 16; ++r) { o[0][r] *= fres; o[1][r] *= fres; } } } while (0)
    AT_WAIT_BAR(3);
    {
        CINIT(pA0, pA1, t_lo);
        const LAS unsigned char* kb = kp0;
#pragma unroll
        for (int d0 = 0; d0 < 4; ++d0) { const bf16x8 b0 = *(const LAS bf16x8*)(kb + d0 * 2048), b1 = *(const LAS bf16x8*)(kb + d0 * 2048 + 512);
            pA0 = __builtin_amdgcn_mfma_f32_32x32x16_bf16(b0, qr[d0], pA0, 0, 0, 0); pA1 = __builtin_amdgcn_mfma_f32_32x32x16_bf16(b1, qr[d0], pA1, 0, 0, 0); }
        DECIDE(pA0, pA1, t_lo);
#pragma unroll
        for (int r = 0; r < 16; ++r) { pA0[r] = __builtin_amdgcn_exp2f(pA0[r]); pA1[r] = __builtin_amdgcn_exp2f(pA1[r]); }
    }
    AT_WAIT_BAR(0);
    DMA_K(3, 0); DMA_V(1, SLOTB);
    ROT();
    {   const LAS unsigned char* kp = kp0 + sl_cur;
#pragma unroll
        for (int j = 0; j < 4; ++j) { kf[2 * j] = *(const LAS bf16x8*)(kp + j * 2048); kf[2 * j + 1] = *(const LAS bf16x8*)(kp + j * 2048 + 512); } }
    AT_WAIT_BAR(2);
    s16x4_t vlo[4], vhi[4]; u32x4 pw0, pw1, pw2, pw3;
#define PKW(P, B) cvtpk_s(P[B], P[(B) + 1])
#define PAF(k) __builtin_bit_cast(bf16x8, pw##k)
#define VFR(i) (bf16x8){vlo[i][0], vlo[i][1], vlo[i][2], vlo[i][3], vhi[i][0], vhi[i][1], vhi[i][2], vhi[i][3]}
#define PIN(x) asm volatile("" : "+v"(x))
#define GAPA(MF, A0, A1, A2, A3, W0, W1, PW) do { MF; sacc += A0; sacc += A1; sacc += A2; sacc += A3; PIN(sacc); W0; W1; PIN(PW); SBAR(); } while (0)
#define EX(v) __builtin_amdgcn_exp2f(v)
#define GAPB(MF, X, B) do { MF; X[B] = EX(X[B]); X[(B) + 1] = EX(X[(B) + 1]); X[(B) + 2] = EX(X[(B) + 2]); X[(B) + 3] = EX(X[(B) + 3]); PIN(X); SBAR(); } while (0)
#define VRD(sl, i) do { vlo[sl] = vtr(vp_ + (((i) >> 2) * 4096 + ((i) & 3) * 1024)); vhi[sl] = vtr(vp_ + (((i) >> 2) * 4096 + ((i) & 3) * 1024 + 512)); } while (0)
#define KRD(j) do { const LAS unsigned char* kn_ = kp0 + sl_next; kf[2 * (j)] = *(const LAS bf16x8*)(kn_ + (j) * 2048); kf[2 * (j) + 1] = *(const LAS bf16x8*)(kn_ + (j) * 2048 + 512); SBAR(); } while (0)
#define STEP(C0, C1, P0, P1, t) do { SBAR(); \
        const LAS unsigned char* vp_ = vp0 + sl_prev; CINIT(C0, C1, t_lo + (t)); \
        VRD(0, 0); SBAR(); float sacc = (P0[0] + P0[1]); \
        GAPA(C0 = __builtin_amdgcn_mfma_f32_32x32x16_bf16(kf[0], qr[0], C0, 0, 0, 0), P0[2], P0[3], P0[4], P0[5], pw0[0] = PKW(P0, 0), pw0[1] = PKW(P0, 2), pw0); \
        VRD(1, 4); SBAR(); GAPA(C1 = __builtin_amdgcn_mfma_f32_32x32x16_bf16(kf[1], qr[0], C1, 0, 0, 0), P0[6], P0[7], P0[8], P0[9], pw0[2] = PKW(P0, 4), pw0[3] = PKW(P0, 6), pw0); \
        VRD(2, 1); SBAR(); GAPA(C0 = __builtin_amdgcn_mfma_f32_32x32x16_bf16(kf[2], qr[1], C0, 0, 0, 0), P0[10], P0[11], P0[12], P0[13], pw1[0] = PKW(P0, 8), pw1[1] = PKW(P0, 10), pw1); \
        VRD(3, 5); SBAR(); GAPA(C1 = __builtin_amdgcn_mfma_f32_32x32x16_bf16(kf[3], qr[1], C1, 0, 0, 0), P0[14], P0[15], P1[0], P1[1], pw1[2] = PKW(P0, 12), pw1[3] = PKW(P0, 14), pw1); \
        GAPA(C0 = __builtin_amdgcn_mfma_f32_32x32x16_bf16(kf[4], qr[2], C0, 0, 0, 0), P1[2], P1[3], P1[4], P1[5], pw2[0] = PKW(P1, 0), pw2[1] = PKW(P1, 2), pw2); \
        GAPA(C1 = __builtin_amdgcn_mfma_f32_32x32x16_bf16(kf[5], qr[2], C1, 0, 0, 0), P1[6], P1[7], P1[8], P1[9], pw2[2] = PKW(P1, 4), pw2[3] = PKW(P1, 6), pw2); \
        GAPA(C0 = __builtin_amdgcn_mfma_f32_32x32x16_bf16(kf[6], qr[3], C0, 0, 0, 0), P1[10], P1[11], P1[12], P1[13], pw3[0] = PKW(P1, 8), pw3[1] = PKW(P1, 10), pw3); \
        GAPA(C1 = __builtin_amdgcn_mfma_f32_32x32x16_bf16(kf[7], qr[3], C1, 0, 0, 0), P1[14], P1[15], 0.f, 0.f, pw3[2] = PKW(P1, 12), pw3[3] = PKW(P1, 14), pw3); \
        l_reg += sacc; \
        DMA_K((t) + 3, sl_cur); DMA_V((t) + 1, sl_next); \
        DECIDE(C0, C1, t_lo + (t)); \
        SBAR(); \
        GAPB(o[0] = __builtin_amdgcn_mfma_f32_32x32x16_bf16(VFR(0), PAF(0), o[0], 0, 0, 0), C0, 0); VRD(0, 2); SBAR(); \
        GAPB(o[1] = __builtin_amdgcn_mfma_f32_32x32x16_bf16(VFR(1), PAF(0), o[1], 0, 0, 0), C0, 4); VRD(1, 6); SBAR(); \
        KRD(0); GAPB(o[0] = __builtin_amdgcn_mfma_f32_32x32x16_bf16(VFR(2), PAF(1), o[0], 0, 0, 0), C0, 8); VRD(2, 3); SBAR(); \
        KRD(1); GAPB(o[1] = __builtin_amdgcn_mfma_f32_32x32x16_bf16(VFR(3), PAF(1), o[1], 0, 0, 0), C0, 12); VRD(3, 7); SBAR(); \
        KRD(2); GAPB(o[0] = __builtin_amdgcn_mfma_f32_32x32x16_bf16(VFR(0), PAF(2), o[0], 0, 0, 0), C1, 0); \
        KRD(3); GAPB(o[1] = __builtin_amdgcn_mfma_f32_32x32x16_bf16(VFR(1), PAF(2), o[1], 0, 0, 0), C1, 4); \
        GAPB(o[0] = __builtin_amdgcn_mfma_f32_32x32x16_bf16(VFR(2), PAF(3), o[0], 0, 0, 0), C1, 8); \
        GAPB(o[1] = __builtin_amdgcn_mfma_f32_32x32x16_bf16(VFR(3), PAF(3), o[1], 0, 0, 0), C1, 12); \
        AT_WAIT_BAR(2); RESC(); ROT(); } while (0)
#define DRAIN(P0, P1) do { float sacc = P0[0] + P0[1]; _Pragma("unroll") for (int r = 2; r < 16; ++r) sacc += P0[r]; _Pragma("unroll") for (int r = 0; r < 16; ++r) sacc += P1[r]; l_reg += sacc; \
        pw0 = (u32x4){PKW(P0, 0), PKW(P0, 2), PKW(P0, 4), PKW(P0, 6)}; pw1 = (u32x4){PKW(P0, 8), PKW(P0, 10), PKW(P0, 12), PKW(P0, 14)}; \
        pw2 = (u32x4){PKW(P1, 0), PKW(P1, 2), PKW(P1, 4), PKW(P1, 6)}; pw3 = (u32x4){PKW(P1, 8), PKW(P1, 10), PKW(P1, 12), PKW(P1, 14)}; SBAR(); \
        const LAS unsigned char* vp_ = vp0 + sl_prev; \
        VRD(0, 0); VRD(1, 4); VRD(2, 1); VRD(3, 5); \
        asm volatile("s_waitcnt lgkmcnt(0)" ::: "memory"); SBAR(); \
        o[0] = __builtin_amdgcn_mfma_f32_32x32x16_bf16(VFR(0), PAF(0), o[0], 0, 0, 0); o[1] = __builtin_amdgcn_mfma_f32_32x32x16_bf16(VFR(1), PAF(0), o[1], 0, 0, 0); \
        o[0] = __builtin_amdgcn_mfma_f32_32x32x16_bf16(VFR(2), PAF(1), o[0], 0, 0, 0); o[1] = __builtin_amdgcn_mfma_f32_32x32x16_bf16(VFR(3), PAF(1), o[1], 0, 0, 0); SBAR(); \
        VRD(0, 2); VRD(1, 6); VRD(2, 3); VRD(3, 7); \
        asm volatile("s_waitcnt lgkmcnt(0)" ::: "memory"); SBAR(); \
        o[0] = __builtin_amdgcn_mfma_f32_32x32x16_bf16(VFR(0), PAF(2), o[0], 0, 0, 0); o[1] = __builtin_amdgcn_mfma_f32_32x32x16_bf16(VFR(1), PAF(2), o[1], 0, 0, 0); \
        o[0] = __builtin_amdgcn_mfma_f32_32x32x16_bf16(VFR(2), PAF(3), o[0], 0, 0, 0); o[1] = __builtin_amdgcn_mfma_f32_32x32x16_bf16(VFR(3), PAF(3), o[1], 0, 0, 0); } while (0)
    int t = 1;
    for (; t + 1 < nt; t += 2) { STEP(pB0, pB1, pA0, pA1, t); STEP(pA0, pA1, pB0, pB1, t + 1); }
    if (t < nt) { STEP(pB0, pB1, pA0, pA1, t); DRAIN(pB0, pB1); } else { DRAIN(pA0, pA1); }
    lsum = l_reg;
    asm volatile("s_waitcnt vmcnt(0) lgkmcnt(0)\n\ts_barrier" ::: "memory");
#undef DMA_K
#undef DMA_V
#undef ROT
#undef SBAR
#undef MX3
#undef CINIT
#undef DECIDE
#undef RESC
#undef PKW
#undef PAF
#undef VFR
#undef PIN
#undef GAPA
#undef EX
#undef GAPB
#undef VRD
#undef KRD
#undef STEP
#undef DRAIN
}
constexpr float NEGBIG = -3.0e38f;
__device__ __forceinline__ void unit(const Frame& F, int l, int bg, int qb, unsigned* cmpdone) {
    int lane_ = F.lane; asm volatile("" : "+v"(lane_));
    const int wid = F.wave, lane = lane_, r32 = lane & 31, hi = lane >> 5, b = bg >> 1, g = bg & 1, rh = wid >> 1, hd = g * 4 + rh, tq = (wid & 1) * 32 + r32, t = qb * 64 + tq;
    LAS unsigned char* lds = F.lds;
    const size_t kvo = (size_t)(44 * b + g) * SEQ * 64;
    bf16x8 qr[4];
    {   const bf16_t* Q = (const bf16_t*)(F.ws + WS_Q + (size_t)__builtin_amdgcn_readfirstlane(b) * (11 * MiB)) + (unsigned)(t * 512 + hd * 64);
#pragma unroll
        for (int d0 = 0; d0 < 4; ++d0) qr[d0] = __builtin_nontemporal_load((const bf16x8*)(Q + d0 * 16 + hi * 8)); }
    float gt0, gt1, gt2;
    {   const float* ZG = (const float*)(F.ws + WS_ZG) + ((size_t)b * SEQ + t) * 24 + g * 12 + rh * 3; const float* gb = INP(F, IN_GATEB) + l * 24 + g * 12 + rh * 3;
        gt0 = sigmoidf_(ZG[0] + gb[0]); gt1 = sigmoidf_(ZG[1] + gb[1]); gt2 = sigmoidf_(ZG[2] + gb[2]); }
    f32x16 oacc[2];
    volatile LAS unsigned* rdy = (volatile LAS unsigned*)(F.lds + MISC_OFF + 252);
    __syncthreads();
    {   const int t_lo0 = qb >= 8 ? qb - 8 : 0;
        tile_dma_issue((const bf16_t*)(F.ws + WS_KV + 4 * KV_STRIDE) + kvo, (const bf16_t*)(F.ws + WS_KV + 5 * KV_STRIDE) + kvo, t_lo0, qb - t_lo0 + 1, lds, wid, lane); }
    LAS float* gpark = (LAS float*)(lds + 3 * BUF + 65536 + 256 + 1024) + F.tid * 4;
    gpark[0] = gt0; gpark[1] = gt1; gpark[2] = gt2;
    if (F.tid == 0) { const unsigned ok = __hip_atomic_load(cmpdone + bg, __ATOMIC_RELAXED, __HIP_MEMORY_SCOPE_AGENT) >= 4u ? 1u : 0u;
        if (ok) group_acquire(group_mode(F.ws, (volatile LAS unsigned*)(F.lds + MISC_OFF + 232)));
        *rdy = ok; }
    __syncthreads();
    const bool early = *rdy != 0u;
    const bf16_t* Kc = (const bf16_t*)(F.ws + WS_KCMP) + (size_t)bg * 8192; const bf16_t* Vc = (const bf16_t*)(F.ws + WS_KCMP) + (size_t)(16 + bg) * 8192;
    LAS unsigned char* cst = lds + 3 * BUF + 32768;
    {
        f32x16 o[2]; float lsum;
        const bf16_t* Kg = (const bf16_t*)(F.ws + WS_KV + 4 * KV_STRIDE) + kvo; const bf16_t* Vg = (const bf16_t*)(F.ws + WS_KV + 5 * KV_STRIDE) + kvo;
        const int t_lo = qb >= 8 ? qb - 8 : 0, nt = qb - t_lo + 1;
        if (early) {
            const unsigned cst0 = (unsigned)(unsigned long long)cst + wid * 1024;
            const bf16_t* kcs = Kc + (size_t)lane * 64 + wid * 8; const bf16_t* vcs = Vc + (size_t)(16 * (wid & 3) + (lane >> 2)) * 64 + (wid >> 2) * 32 + (lane & 3) * 8;
            glds16(kcs, (unsigned)__builtin_amdgcn_readfirstlane(cst0)); glds16(vcs, (unsigned)__builtin_amdgcn_readfirstlane(cst0 + 8192));
            glds16(kcs + 4096, (unsigned)__builtin_amdgcn_readfirstlane(cst0 + BUF)); glds16(vcs + 4096, (unsigned)__builtin_amdgcn_readfirstlane(cst0 + BUF + 8192)); }
        tile_dma<false>(o, lsum, Kg, Vg, t_lo, nt, qb, 0u, qr, lds, tq, wid, lane, r32, hi);
        lsum += xhalf(lsum);
        const float gate = gpark[2] / lsum;
#pragma unroll
        for (int r = 0; r < 16; ++r) { oacc[0][r] = o[0][r] * gate; oacc[1][r] = o[1][r] * gate; }
    }
    if (!early) {
        if (F.tid == 0) { unsigned sp = 0;
            while (__hip_atomic_load(cmpdone + bg, __ATOMIC_RELAXED, __HIP_MEMORY_SCOPE_AGENT) < 4u) { __builtin_amdgcn_s_sleep(2); if (++sp > (1u << 22)) break; }
            group_acquire(group_mode(F.ws, (volatile LAS unsigned*)(F.lds + MISC_OFF + 232))); }
        __syncthreads();
        Stg sc0, sc1; stage_load(sc0, Kc, Vc, 0, wid, lane); stage_load(sc1, Kc, Vc, 64, wid, lane); stage_write(sc0, cst, wid, lane); stage_write(sc1, cst + BUF, wid, lane);
        __syncthreads();
    }
    LAS float* impp = (LAS float*)(lds + 3 * BUF);
    LAS unsigned* selm = (LAS unsigned*)(lds + 3 * BUF + 65536);
    LAS float* ssq = (LAS float*)(lds + 3 * BUF + 65536 + 256);
    LAS unsigned char* park = lds + 3 * BUF + (size_t)F.tid * 16;
    {
        f32x16 p[4];
#pragma unroll
        for (int x = 0; x < 4; ++x)
#pragma unroll
            for (int r = 0; r < 16; ++r) p[x][r] = 0.f;
        qkt(p[0], p[1], cst, qr, r32, hi); qkt(p[2], p[3], cst + BUF, qr, r32, hi);
        float mx = -1e30f; const int clim = ((t - 31) >> 4) - 4 * hi;
#pragma unroll
        for (int x = 0; x < 4; ++x)
#pragma unroll
            for (int r = 0; r < 16; ++r) { const int c0 = 32 * x + (r & 3) + 8 * (r >> 2); const bool v = (c0 <= clim) && !(x == 3 && r == 15 && hi == 1); p[x][r] = v ? p[x][r] : NEGBIG; mx = fmaxf(mx, p[x][r]); }
        mx = fmaxf(mx, xhalf(mx)); float sm = 0.f;
#pragma unroll
        for (int x = 0; x < 4; ++x)
#pragma unroll
            for (int r = 0; r < 16; ++r) { p[x][r] = __builtin_amdgcn_exp2f(p[x][r] - mx); sm += p[x][r]; }
        sm += xhalf(sm); const float inv = sm > 0.f ? 1.0f / sm : 0.f;
#pragma unroll
        for (int x = 0; x < 4; ++x)
#pragma unroll
            for (int r = 0; r < 16; ++r) p[x][r] *= inv;
        float eprev = 0.f;
#pragma unroll
        for (int i = 0; i < 16; ++i) { const int x = i >> 2, k = i & 3; const float gsum = (p[x][4 * k] + p[x][4 * k + 1]) + (p[x][4 * k + 2] + p[x][4 * k + 3]), eo = xhalf(p[x][4 * k + 3]);
            impp[(rh * 64 + tq) * 32 + 2 * i + hi] = gsum + (hi ? eo : eprev); eprev = eo; }
        f32x16 oc[2]; oc[0] = (f32x16){}; oc[1] = (f32x16){};
        pv(oc, cst, p[0], p[1], lane, hi); pv(oc, cst + BUF, p[2], p[3], lane, hi);
        const float gc0 = gpark[0];
#pragma unroll
        for (int r = 0; r < 16; ++r) { oacc[0][r] += oc[0][r] * gc0; oacc[1][r] += oc[1][r] * gc0; }
    }
    __syncthreads();
    const bf16_t* Kg = (const bf16_t*)(F.ws + WS_KV + 2 * KV_STRIDE) + kvo; const bf16_t* Vg = (const bf16_t*)(F.ws + WS_KV + 3 * KV_STRIDE) + kvo;
    tile_dma_issue(Kg, Vg, 0, qb + 1, lds, wid, lane);
    {
        const int qq = 8 * wid + (lane >> 3), sub = lane & 7;
        unsigned smask = qb >= 31 ? 0xffffffffu : ((2u << qb) - 1u);
        if (qb >= 8) {
            float v[4];
#pragma unroll
            for (int e = 0; e < 4; ++e) { const int j = 4 * sub + e; const float sv = (impp[qq * 32 + j] + impp[(64 + qq) * 32 + j]) + (impp[(128 + qq) * 32 + j] + impp[(192 + qq) * 32 + j]); v[e] = (j >= 1 && j <= qb - 2) ? sv : -1e30f; }
            smask = 1u | (3u << (qb - 1));
#pragma unroll 1
            for (int k = 0; k < 5; ++k) { float best = v[0]; int bi = 4 * sub;
#pragma unroll
                for (int e = 1; e < 4; ++e) { const bool gt = v[e] > best; best = gt ? v[e] : best; bi = gt ? 4 * sub + e : bi; }
#pragma unroll
                for (int sft = 0; sft < 3; ++sft) {
                    float ov; int oi;
                    if (sft == 0) { ov = __int_as_float(__builtin_amdgcn_update_dpp(0, __float_as_int(best), 0xB1, 0xf, 0xf, true)); oi = __builtin_amdgcn_update_dpp(0, bi, 0xB1, 0xf, 0xf, true); }
                    else if (sft == 1) { ov = __int_as_float(__builtin_amdgcn_update_dpp(0, __float_as_int(best), 0x4E, 0xf, 0xf, true)); oi = __builtin_amdgcn_update_dpp(0, bi, 0x4E, 0xf, 0xf, true); }
                    else { ov = __int_as_float(__builtin_amdgcn_update_dpp(0, __float_as_int(best), 0x141, 0xf, 0xf, true)); oi = __builtin_amdgcn_update_dpp(0, bi, 0x141, 0xf, 0xf, true); }
                    const bool take = (ov > best) || (ov == best && oi < bi); best = take ? ov : best; bi = take ? oi : bi; }
                smask |= 1u << bi;
#pragma unroll
                for (int e = 0; e < 4; ++e) v[e] = (4 * sub + e == bi) ? -3.4e38f : v[e]; }
        }
        if (sub == 0) selm[qq] = smask;
    }
    __syncthreads();
    const unsigned mask = selm[tq];
#pragma unroll
    for (int d0 = 0; d0 < 2; ++d0)
#pragma unroll
        for (int q4 = 0; q4 < 4; ++q4) *(LAS f32x4*)(park + (d0 * 4 + q4) * 8192) = (f32x4){oacc[d0][4 * q4], oacc[d0][4 * q4 + 1], oacc[d0][4 * q4 + 2], oacc[d0][4 * q4 + 3]};
    f32x16 o[2]; float lsum;
    tile_dma<true>(o, lsum, Kg, Vg, 0, qb + 1, qb, mask, qr, lds, tq, wid, lane, r32, hi);
#pragma unroll
    for (int d0 = 0; d0 < 2; ++d0)
#pragma unroll
        for (int q4 = 0; q4 < 4; ++q4) { const f32x4 v = *(const LAS f32x4*)(park + (d0 * 4 + q4) * 8192); oacc[d0][4 * q4] = v[0]; oacc[d0][4 * q4 + 1] = v[1]; oacc[d0][4 * q4 + 2] = v[2]; oacc[d0][4 * q4 + 3] = v[3]; }
    lsum += xhalf(lsum);
    const float g1 = gpark[1] / lsum;
    bf16_t* MX = (bf16_t*)(F.ws + WS_MIXED) + ((size_t)b * SEQ + t) * D + hd * 64;
    float ss = 0.f;
#pragma unroll
    for (int d0 = 0; d0 < 2; ++d0)
#pragma unroll
        for (int i = 0; i < 4; ++i) {
            const float v0 = oacc[d0][4 * i] + g1 * o[d0][4 * i], v1 = oacc[d0][4 * i + 1] + g1 * o[d0][4 * i + 1], v2 = oacc[d0][4 * i + 2] + g1 * o[d0][4 * i + 2], v3 = oacc[d0][4 * i + 3] + g1 * o[d0][4 * i + 3];
            ss += (v0 * v0 + v1 * v1) + (v2 * v2 + v3 * v3);
            u32x2 w; w.x = cvt_pk_bf16(v0, v1); w.y = cvt_pk_bf16(v2, v3); *(u32x2*)(MX + d0 * 32 + 8 * i + 4 * hi) = w; }
    ss += xhalf(ss);
    if (hi == 0) ssq[tq * 4 + rh] = ss;
    __syncthreads();
    if (F.tid < 64) { float* SSN = (float*)(F.ws + WS_SSN); SSN[((size_t)b * SEQ + qb * 64 + F.tid) * 2 + g] = (ssq[F.tid * 4] + ssq[F.tid * 4 + 1]) + (ssq[F.tid * 4 + 2] + ssq[F.tid * 4 + 3]); }
}
}

namespace lr {
typedef float f32x16 __attribute__((ext_vector_type(16)));
constexpr int WREG = 16768;
constexpr int YROW = 80;
__device__ __forceinline__ float xhalf(float v) { return __shfl_xor(v, 32); }
__device__ __forceinline__ void zx_load(u32x4 (&z)[9], const bf16_t* ZXb, int t0, int lane) {
#pragma unroll
    for (int j = 0; j < 9; ++j) { int p = 64 * j + lane; p = p < 67 * 8 ? p : 67 * 8 - 1; const int row = p >> 3, c8 = p & 7, t = t0 - 3 + row; const u32x4 v = *(const u32x4*)(ZXb + (size_t)(t > 0 ? t : 0) * 512 + c8 * 8);
        const unsigned keep = t >= 0 ? 0xffffffffu : 0u; z[j] = (u32x4){v.x & keep, v.y & keep, v.z & keep, v.w & keep}; }
}
__device__ __forceinline__ void zx_park(const u32x4 (&z)[9], LAS unsigned char* ZT, int lane) {
#pragma unroll
    for (int j = 0; j < 9; ++j) { const int p = 64 * j + lane, row = p >> 3, c8 = p & 7; if (p < 67 * 8) *(LAS u32x4*)(ZT + row * 128 + ((c8 ^ (row & 7)) * 16)) = z[j]; }
}
__device__ __forceinline__ void item(const Frame& F, int l, int it) {
    int lane_ = F.lane; asm volatile("" : "+v"(lane_));
    const int b = it >> 4, n = (it >> 1) & 7, hc = it & 1, lane = lane_, w = F.wave, d1 = lane & 31, hi = lane >> 5, ch = 64 * n + 32 * hc + d1;
    LAS unsigned char* XCw = F.lds + w * WREG; LAS unsigned char* ZT = XCw + 8192; LAS unsigned char* YT = XCw;
    LAS float* comp = (LAS float*)(F.lds + 8 * WREG);
    LAS unsigned char* BfL = F.lds + 8 * WREG + 4096;
    LAS float* cwl = (LAS float*)(F.lds + RSTD_OFF);
    const bf16_t* ZXb = (const bf16_t*)(F.ws + WS_ZX + (size_t)b * CH_Q) + (size_t)b * SEQ * 512 + 64 * n;
    __syncthreads();
    for (int i = w * 64 + lane; i < 320; i += 512) cwl[i] = i < 256 ? INP(F, IN_LCW)[(size_t)(l * 4 + (i >> 6)) * 512 + 64 * n + (i & 63)] : INP(F, IN_LCB)[l * 512 + 64 * n + (i - 256)];
    {   u32x4 z0[9]; zx_load(z0, ZXb, 64 * w, lane); zx_park(z0, ZT, lane); }
    {   const bf16_t* W = (const bf16_t*)(F.ws + WS_WTS + (size_t)l * WTS_LAYER + WO_LRUW) + (size_t)n * 128 * 64; const int gk = F.tid >> 6, gt = gk >> 2, ks = gk & 3;
        *(LAS bf16x8*)(BfL + F.tid * 16) = *(const bf16x8*)(W + (64 * gt + 32 * hc + d1) * 64 + 16 * ks + 8 * hi); }
    const float ba = INP(F, IN_LBA)[l * 512 + ch], bx = INP(F, IN_LBX)[l * 512 + ch], ls8l2 = -8.0f * LOG2E * log1pf(expf(-INP(F, IN_LLAM)[l * 512 + ch]));
    float hcarry = 0.f;
    __syncthreads();
    for (int sw = 0; sw < 4; ++sw) {
        const int t0 = 512 * sw + 64 * w;
        const bf16_t* ZYr = (const bf16_t*)(F.ws + WS_ZY + (size_t)b * CH_Q) + ((size_t)b * SEQ + t0) * 512 + 64 * n + 32 * hc;
        u32x4 zyr[4];
#pragma unroll
        for (int j = 0; j < 4; ++j) zyr[j] = __builtin_nontemporal_load((const u32x4*)(ZYr + (size_t)(16 * j + (lane >> 2)) * 512 + (lane & 3) * 8));
#pragma unroll 1
        for (int c8 = 0; c8 < 8; ++c8) {
            float x3[8], x2[8], x1[8], x0[8];
            unpack8(*(const LAS u32x4*)(ZT + (lane + 0) * 128 + ((c8 ^ ((lane + 0) & 7)) * 16)), x3); unpack8(*(const LAS u32x4*)(ZT + (lane + 1) * 128 + ((c8 ^ ((lane + 1) & 7)) * 16)), x2);
            unpack8(*(const LAS u32x4*)(ZT + (lane + 2) * 128 + ((c8 ^ ((lane + 2) & 7)) * 16)), x1); unpack8(*(const LAS u32x4*)(ZT + (lane + 3) * 128 + ((c8 ^ ((lane + 3) & 7)) * 16)), x0);
            float o[8];
#pragma unroll
            for (int h4 = 0; h4 < 2; ++h4) {
                const LAS float* wp = cwl + c8 * 8 + 4 * h4;
                const f32x4 wb = *(const LAS f32x4*)(wp + 256), w3 = *(const LAS f32x4*)(wp), w2 = *(const LAS f32x4*)(wp + 64), w1 = *(const LAS f32x4*)(wp + 128), w0 = *(const LAS f32x4*)(wp + 192);
                const f32x4 v3 = {x3[4 * h4], x3[4 * h4 + 1], x3[4 * h4 + 2], x3[4 * h4 + 3]}, v2 = {x2[4 * h4], x2[4 * h4 + 1], x2[4 * h4 + 2], x2[4 * h4 + 3]};
                const f32x4 v1 = {x1[4 * h4], x1[4 * h4 + 1], x1[4 * h4 + 2], x1[4 * h4 + 3]}, v0 = {x0[4 * h4], x0[4 * h4 + 1], x0[4 * h4 + 2], x0[4 * h4 + 3]};
                const f32x4 r = wb + w3 * v3 + w2 * v2 + w1 * v1 + w0 * v0;
                o[4 * h4] = r[0]; o[4 * h4 + 1] = r[1]; o[4 * h4 + 2] = r[2]; o[4 * h4 + 3] = r[3]; }
            u32x4 pk; pk.x = pk2(o[0], o[1]); pk.y = pk2(o[2], o[3]); pk.z = pk2(o[4], o[5]); pk.w = pk2(o[6], o[7]);
            *(LAS u32x4*)(XCw + c8 * 1024 + lane * 16) = pk; }
        f32x16 acc[2][2];
#pragma unroll
        for (int tm = 0; tm < 2; ++tm) { acc[tm][0] = (f32x16){}; acc[tm][1] = (f32x16){}; }
#pragma unroll
        for (int ks = 0; ks < 4; ++ks) { const bf16x8 A0 = *(const LAS bf16x8*)(XCw + (2 * ks + hi) * 1024 + d1 * 16), A1 = *(const LAS bf16x8*)(XCw + (2 * ks + hi) * 1024 + (d1 + 32) * 16);
#pragma unroll
            for (int gt = 0; gt < 2; ++gt) { const bf16x8 Bq = *(const LAS bf16x8*)(BfL + ((gt * 4 + ks) * 64 + lane) * 16);
                acc[0][gt] = __builtin_amdgcn_mfma_f32_32x32x16_bf16(A0, Bq, acc[0][gt], 0, 0, 0); acc[1][gt] = __builtin_amdgcn_mfma_f32_32x32x16_bf16(A1, Bq, acc[1][gt], 0, 0, 0); } }
        float a[2][16], u[2][16]; float Ac = 1.f, Uc = 0.f;
        const int cx = 32 * hc + d1;
#pragma unroll
        for (int tm = 0; tm < 2; ++tm) {
#pragma unroll
            for (int r = 0; r < 16; ++r) { const int tok = 32 * tm + (r & 3) + 8 * (r >> 2) + 4 * hi;
                const float xcv = bf2f(*(const LAS bf16_t*)(XCw + (cx >> 3) * 1024 + tok * 16 + (cx & 7) * 2)), ra = acc[tm][0][r] + ba, ri = acc[tm][1][r] + bx;
                const float rr = __builtin_amdgcn_rcpf(1.0f + __builtin_amdgcn_exp2f(-LOG2E * ra)), ig = __builtin_amdgcn_rcpf(1.0f + __builtin_amdgcn_exp2f(-LOG2E * ri));
                a[tm][r] = __builtin_amdgcn_exp2f(ls8l2 * rr); u[tm][r] = __builtin_amdgcn_sqrtf(fmaxf(1.0f - a[tm][r] * a[tm][r], 0.f)) * (ig * xcv); }
#pragma unroll
            for (int i = 0; i < 4; ++i) {
                const float Ag = (a[tm][4 * i] * a[tm][4 * i + 1]) * (a[tm][4 * i + 2] * a[tm][4 * i + 3]);
                const float Ug = ((u[tm][4 * i] * a[tm][4 * i + 1] + u[tm][4 * i + 1]) * a[tm][4 * i + 2] + u[tm][4 * i + 2]) * a[tm][4 * i + 3] + u[tm][4 * i + 3];
                const float Agp = xhalf(Ag), Ugp = xhalf(Ug);
                const float A1 = hi ? Agp : Ag, U1 = hi ? Ugp : Ug, A2 = hi ? Ag : Agp, U2 = hi ? Ug : Ugp;
                Uc = A2 * (A1 * Uc + U1) + U2; Ac *= A1 * A2; }
        }
        LAS float* cb_ = comp + (sw & 1) * 512;
        if (hi == 0) *(LAS f32x2*)(cb_ + (w * 32 + d1) * 2) = (f32x2){Ac, Uc};
#pragma unroll
        for (int j = 0; j < 4; ++j) *(LAS u32x4*)(YT + (16 * j + (lane >> 2)) * YROW + (lane & 3) * 16) = zyr[j];
        u32x4 zn[9];
        if (sw < 3) zx_load(zn, ZXb, t0 + 512, lane);
        asm volatile("s_waitcnt lgkmcnt(0)" ::: "memory"); __builtin_amdgcn_s_barrier(); asm volatile("" ::: "memory");
        float h = hcarry, hin = 0.f;
#pragma unroll
        for (int w2 = 0; w2 < 8; ++w2) { const f32x2 cu = *(const LAS f32x2*)(cb_ + (w2 * 32 + d1) * 2); if (w2 == w) hin = h; h = cu.x * h + cu.y; }
        hcarry = h;
        h = hin;
#pragma unroll
        for (int tm = 0; tm < 2; ++tm) {
            float zyv[16];
#pragma unroll
            for (int q = 0; q < 16; ++q) zyv[q] = bf2f(*(const LAS bf16_t*)(YT + (32 * tm + 8 * (q >> 2) + 4 * hi + (q & 3)) * YROW + d1 * 2));
#pragma unroll
            for (int q = 0; q < 16; ++q) zyv[q] = gelu_tanh(zyv[q]);
#pragma unroll
            for (int i = 0; i < 4; ++i) {
                const float Ag = (a[tm][4 * i] * a[tm][4 * i + 1]) * (a[tm][4 * i + 2] * a[tm][4 * i + 3]);
                const float Ug = ((u[tm][4 * i] * a[tm][4 * i + 1] + u[tm][4 * i + 1]) * a[tm][4 * i + 2] + u[tm][4 * i + 2]) * a[tm][4 * i + 3] + u[tm][4 * i + 3];
                const float Agp = xhalf(Ag), Ugp = xhalf(Ug);
                const float A1 = hi ? Agp : Ag, U1 = hi ? Ugp : Ug, A2 = hi ? Ag : Agp, U2 = hi ? Ug : Ugp;
                const float hmid = A1 * h + U1; float hh = hi ? hmid : h; h = A2 * hmid + U2;
#pragma unroll
                for (int e = 0; e < 4; ++e) { hh = a[tm][4 * i + e] * hh + u[tm][4 * i + e]; const int tok = 32 * tm + 8 * i + 4 * hi + e;
                    LAS bf16_t* yp = (LAS bf16_t*)(YT + tok * YROW + d1 * 2); *yp = (bf16_t)f2bf(hh * zyv[4 * i + e]); } } }
        bf16_t* MX = (bf16_t*)(F.ws + WS_MIXED) + ((size_t)b * SEQ + t0) * D + 512 + 64 * n + 32 * hc;
#pragma unroll
        for (int j = 0; j < 4; ++j) *(u32x4*)(MX + (size_t)(16 * j + (lane >> 2)) * D + (lane & 3) * 8) = *(const LAS u32x4*)(YT + (16 * j + (lane >> 2)) * YROW + (lane & 3) * 16);
        {   float ss = 0.f;
#pragma unroll
            for (int j = 0; j < 4; ++j) { float v[8]; unpack8(*(const LAS u32x4*)(YT + lane * YROW + j * 16), v);
#pragma unroll
                for (int e = 0; e < 8; ++e) ss += v[e] * v[e]; }
            ((float*)(F.ws + WS_SSL))[((size_t)b * SEQ + t0 + lane) * 16 + 2 * n + hc] = ss; }
        if (sw < 3) zx_park(zn, ZT, lane);
    }
}
}

namespace cp {
typedef float f32x16 __attribute__((ext_vector_type(16)));
__device__ __forceinline__ void item(const Frame& F, int l, int it, unsigned* cmpdone) {
    int lane_ = F.lane; asm volatile("" : "+v"(lane_));
    const int kv = it >> 5, bg = (it >> 1) & 15, c0 = (it & 1) * 64, w = F.wave, lane = lane_, r32 = lane & 31, hi = lane >> 5;
    LAS unsigned char* lds = F.lds;
    const bf16_t* src = (const bf16_t*)(F.ws + WS_KV + (size_t)kv * KV_STRIDE + (size_t)(bg >> 1) * CH_KV) + (size_t)bg * SEQ * 64 + (size_t)(16 * (c0 + lane)) * 64 + w * 8;
    const bf16_t* W1F = (const bf16_t*)(F.ws + WS_WTS + (size_t)l * WTS_LAYER + WO_CW1) + ((size_t)(kv * 8 + w) * 128 * 64 + lane) * 8;
    __syncthreads();
    f32x16 acc[2]; acc[0] = (f32x16){}; acc[1] = (f32x16){};
    u32x4 sa[4]; bf16x8 Bf[4][4];
#pragma unroll
    for (int s4 = 0; s4 < 4; ++s4) { sa[s4] = *(const u32x4*)(src + (size_t)s4 * 64);
#pragma unroll
        for (int q = 0; q < 4; ++q) Bf[s4][q] = *(const bf16x8*)(W1F + (size_t)(4 * s4 + q) * 512); }
    *(LAS u32x4*)(lds + w * 1024 + lane * 16) = sa[0];
    LDS_WAIT(); __builtin_amdgcn_s_barrier(); asm volatile("" ::: "memory");
#pragma unroll 1
    for (int s4 = 0; s4 < 32; s4 += 4) {
#pragma unroll
        for (int j = 0; j < 4; ++j) { const int sl = s4 + j;
            LAS unsigned char* buf = lds + (sl & 1) * 8192;
#pragma unroll
            for (int q = 0; q < 4; ++q) { const bf16x8 A0 = *(const LAS bf16x8*)(buf + (2 * q + hi) * 1024 + r32 * 16), A1 = *(const LAS bf16x8*)(buf + (2 * q + hi) * 1024 + (r32 + 32) * 16);
                acc[0] = __builtin_amdgcn_mfma_f32_32x32x16_bf16(A0, Bf[j][q], acc[0], 0, 0, 0); acc[1] = __builtin_amdgcn_mfma_f32_32x32x16_bf16(A1, Bf[j][q], acc[1], 0, 0, 0); }
            if (sl + 1 < 32) *(LAS u32x4*)(lds + ((sl + 1) & 1) * 8192 + w * 1024 + lane * 16) = sa[(j + 1) & 3];
            if (sl + 4 < 32) { sa[j] = *(const u32x4*)(src + (size_t)(sl + 4) * 64);
#pragma unroll
                for (int q = 0; q < 4; ++q) Bf[j][q] = *(const bf16x8*)(W1F + (size_t)(4 * (sl + 4) + q) * 512); }
            LDS_WAIT(); __builtin_amdgcn_s_barrier(); asm volatile("" ::: "memory");
        }
    }
    {
        LAS unsigned char* H = lds + 16384; const int nn = 32 * w + r32; const float pb = ((const float*)(F.ws + WS_POSB))[(l * 2 + kv) * 256 + nn];
#pragma unroll
        for (int tm = 0; tm < 2; ++tm)
#pragma unroll
            for (int r = 0; r < 16; ++r) { const int c = 32 * tm + (r & 3) + 8 * (r >> 2) + 4 * hi; *(LAS bf16_t*)(H + (nn >> 3) * 1024 + c * 16 + (nn & 7) * 2) = (bf16_t)f2bf(gelu_tanh(acc[tm][r] + pb)); }
    }
    __syncthreads();
    if (w < 4) {
        const int tm = w & 1, dn = w >> 1, dd = 32 * dn + r32; const LAS unsigned char* H = lds + 16384;
        const bf16_t* W2 = (const bf16_t*)(F.ws + WS_WTS + (size_t)l * WTS_LAYER + WO_CW2) + ((size_t)kv * 64 + dd) * 256;
        f32x16 o = (f32x16){};
#pragma unroll
        for (int ks = 0; ks < 16; ++ks) { const bf16x8 A = *(const LAS bf16x8*)(H + (2 * ks + hi) * 1024 + (32 * tm + r32) * 16), B = *(const bf16x8*)(W2 + 16 * ks + 8 * hi);
            o = __builtin_amdgcn_mfma_f32_32x32x16_bf16(A, B, o, 0, 0, 0); }
        const float b2 = INP(F, IN_CB2)[(size_t)(l * 2 + kv) * 64 + dd];
        bf16_t* dst = (bf16_t*)(F.ws + WS_KCMP) + ((size_t)(kv * 16 + bg) * 128 + c0) * 64 + dd;
#pragma unroll
        for (int r = 0; r < 16; ++r) { const int c = 32 * tm + (r & 3) + 8 * (r >> 2) + 4 * hi; dst[(size_t)c * 64] = (bf16_t)f2bf(c0 + c < 127 ? o[r] + b2 : 0.f); }
    }
    asm volatile("s_waitcnt vmcnt(0)" ::: "memory"); __syncthreads();
    if (F.tid == 0) { group_release(group_mode(F.ws, (volatile LAS unsigned*)(F.lds + MISC_OFF + 232))); __hip_atomic_fetch_add(cmpdone + bg, 1u, __ATOMIC_RELAXED, __HIP_MEMORY_SCOPE_AGENT); }
}
}

__device__ __forceinline__ void fix_rows(const Frame& F, int l, int pm) {
    const float* gf = (const float*)(F.ws + WS_GFIRST); const float* gl = (const float*)(F.ws + WS_GLAST); const float* uf = (const float*)(F.ws + WS_UFIRST);
    const float* cw = (const float*)(F.ws + WS_FCW) + (size_t)l * 4 * FF; bf16_t* ACT = (bf16_t*)(F.ws + WS_ACT);
    float g0[6], g1[6], h2[6], h1[6], w0[6], w1[6], w2[6], bb[6], u0[6], u1[6];
    const bool prev = (pm & 7) != 0;
#pragma unroll
    for (int j = 0; j < 6; ++j) { int col = F.tid + 512 * j; col = col < FF ? col : FF - 1;
        g0[j] = gf[((size_t)pm * 2) * FF + col]; g1[j] = gf[((size_t)pm * 2 + 1) * FF + col];
        h2[j] = prev ? gl[((size_t)(pm - 1) * 2) * FF + col] : 0.f; h1[j] = prev ? gl[((size_t)(pm - 1) * 2 + 1) * FF + col] : 0.f;
        w0[j] = cw[col]; w1[j] = cw[FF + col]; w2[j] = cw[2 * FF + col]; bb[j] = cw[3 * FF + col];
        u0[j] = uf[((size_t)pm * 2) * FF + col]; u1[j] = uf[((size_t)pm * 2 + 1) * FF + col]; }
#pragma unroll
    for (int j = 0; j < 6; ++j) { const int col = F.tid + 512 * j;
        const float c0 = bb[j] + w0[j] * h2[j] + w1[j] * h1[j] + w2[j] * g0[j], c1 = bb[j] + w0[j] * h1[j] + w1[j] * g0[j] + w2[j] * g1[j];
        if (col < FF) { ACT[((size_t)pm * 256) * FF + col] = (bf16_t)f2bf(siluf_(c0) * u0[j]); ACT[((size_t)pm * 256 + 1) * FF + col] = (bf16_t)f2bf(siluf_(c1) * u1[j]); } }
}
__device__ __forceinline__ void ph_final(const Frame& F) {
    const float* rowss = (const float*)(F.ws + WS_ROWSS); const float* g = INP(F, IN_FING);
    for (int row = F.bid * 8 + F.wave; row < T; row += F.G * 8) {
        float s = F.lane < 16 ? rowss[(size_t)row * 16 + F.lane] : 0.f; s = wave_sum(s); const float rs = rsqrtf(s * (1.0f / D) + EPS);
#pragma unroll
        for (int j = 0; j < 4; ++j) { const int col = j * 256 + F.lane * 4; f32x4 v = *(const f32x4*)(F.out + (size_t)row * D + col); const f32x4 gv = *(const f32x4*)(g + col);
            v = v * rs * gv; *(f32x4*)(F.out + (size_t)row * D + col) = v; } }
}

constexpr int N_PHASES = 2 + 5 * NL;
#ifndef PH_MASK
#define PH_MASK 0xffff
#endif
#define PHON(b) ((PH_MASK >> (b)) & 1)
#ifndef REP_SUB
#define REP_SUB -1
#endif
#define REPS(k) (REP_SUB == (k) ? 2 : 1)
#ifndef FAST_WIN
#define FAST_WIN 1
#endif
#ifndef FAST_SEL
#define FAST_SEL 1
#endif
#define PH_FRAME() Frame F; { size_t z_ = 0; int t_, b_ = blockIdx.x, wv_ = wave0; asm volatile("" : "+s"(z_), "+s"(wv_), "+s"(b_)); \
        asm volatile("v_mbcnt_lo_u32_b32 %0, -1, 0\n\tv_mbcnt_hi_u32_b32 %0, -1, %0" : "=v"(t_)); t_ += wv_ * 64; \
        F.ws = args.ws + z_; F.out = args.out + z_; F.tid = t_; F.lane = t_ & 63; F.wave = __builtin_amdgcn_readfirstlane(t_ >> 6); F.bid = b_; F.G = gridDim.x; \
        F.lds = (LAS unsigned char*)lds_raw + (unsigned)z_; F.inl = (volatile LAS unsigned long long*)(F.lds + MISC_OFF); }
#define PHASE(k, ...) if (lo <= (k) && (k) < hi) { { PH_FRAME(); __VA_ARGS__ } if ((k) + 1 < hi) GRID_BAR(); }
#define PHASE_WIN(k, l) if (lo <= (k) && (k) < hi) { PH_FRAME(); if (PHON(3)) ph_win<l>(F); \
    if ((k) + 1 < hi) { if (lru_early) { \
        group_arrive(args.ws, GST, wave0); \
        if (F.bid >= 128) { \
            if (F.tid == 0) { unsigned* z2 = (unsigned*)(args.ws + WS_CTL) + CW_Z2 + 64 * ((l) * 8 + (F.bid & 7)); XB_SPIN(xb_ld(z2) < 32u, xbar); group_acquire(group_mode(args.ws, GST)); } \
            __syncthreads(); \
            lr::item(F, l, (F.bid & 7) * 16 + ((F.bid >> 3) - 16)); \
            asm volatile("s_waitcnt vmcnt(0)" ::: "memory"); __syncthreads(); \
            if (F.tid == 0) { group_release(group_mode(args.ws, GST)); (void)xb_add((unsigned*)(args.ws + WS_CTL) + CW_LDONE + 64 * ((l) * 8 + (F.bid & 7)), 1u); } } \
        group_wait(args.ws, xbar, GST, wave0); \
    } else GROUP_BAR(); } }
#define PHASE_MIXW(k, l) if (lru_early && lo <= (k) && (k) + 1 < hi) { { PH_FRAME(); ph_mix<l, lru_early>(F); ph_wout_dyn<l>(F); } if ((k) + 2 < hi) GROUP_BAR(); } else { \
    PHASE_G(k, ph_mix<l, lru_early>(F);) PHASE_G((k) + 1, if (PHON(9)) ph_wout<l>(F);) }
#define PHASE_G(k, ...) if (lo <= (k) && (k) < hi) { { PH_FRAME(); __VA_ARGS__ } if ((k) + 1 < hi) GROUP_BAR(); }

template <int l> __device__ __forceinline__ void ph_win(const Frame& F) {
    unsigned char* wl = F.ws + WS_WTS + (size_t)l * WTS_LAYER;
    pg8::Gemm g{(const bf16_t*)(F.ws + WS_XG), (const bf16_t*)(wl + WO_WIN), T, NIN, D}; pg8::StaticOrder S; S.init(T, NIN, F.G, F.bid); S.zf = 1;
    EpiIn E{F.ws, l};
    pg8::gemm_phase<EpiIn, pg8::StaticOrder>(F.lds, F.lds + HALO_OFF, g, S, E, F.tid);
}
constexpr int CW_QUEUE = 18432, CW_CMPDONE = 8448;
template <int l, bool le> __device__ __forceinline__ void ph_mix(const Frame& F) {
    const int bq = F.bid & 7;
    unsigned* ctl = (unsigned*)(F.ws + WS_CTL); unsigned* qhead = ctl + CW_QUEUE + 64 * (l * 8 + bq); unsigned* cmpdone = ctl + CW_CMPDONE + 64 * l;
    volatile LAS unsigned* slot = (volatile LAS unsigned*)(F.lds + MISC_OFF + 248);
    for (;;) {
        __syncthreads();
        if (F.tid == 0) *slot = __hip_atomic_fetch_add(qhead, 1u, __ATOMIC_RELAXED, __HIP_MEMORY_SCOPE_AGENT);
        __syncthreads();
        const int it = (int)*slot;
        if (it >= (le ? 8 + 64 : 8 + 16 + 64)) break;
        if (it < 8) { if (PHON(4)) cp::item(F, l, (it >> 2) * 32 + (bq * 2 + ((it >> 1) & 1)) * 2 + (it & 1), cmpdone); }
        else if (!le && it < 24) { if constexpr (!le) { if (PHON(5)) lr::item(F, l, bq * 16 + (it - 8)); } }
        else { const int k = it - (le ? 8 : 24); if (PHON(6)) at::unit(F, l, bq * 2 + (k & 1), 31 - (k >> 1), cmpdone);
            if constexpr (le) {
                asm volatile("s_waitcnt vmcnt(0)" ::: "memory"); __syncthreads();
                if (F.tid == 0) { group_release(group_mode(F.ws, (volatile LAS unsigned*)(F.lds + MISC_OFF + 232)));
                    __hip_atomic_fetch_add(ctl + CW_PDONE + 64 * (l * 64 + bq * 8 + ((31 - (k >> 1)) >> 2)), 1u, __ATOMIC_RELAXED, __HIP_MEMORY_SCOPE_AGENT); } } }
    }
}
struct OneUnit { int pm, pn; __device__ __forceinline__ bool next(int i, pg8::Unit& u) const { if (i) return false; u.pm = pm; u.pn = pn; return true; } };
template <int l> __device__ __forceinline__ void ph_wout_dyn(const Frame& F) {
    unsigned char* wl = F.ws + WS_WTS + (size_t)l * WTS_LAYER; unsigned* ctl = (unsigned*)(F.ws + WS_CTL); const int bq = F.bid & 7;
    volatile LAS unsigned* slot = (volatile LAS unsigned*)(F.lds + MISC_OFF + 248);
    __syncthreads();
    if (F.tid == 0) { const unsigned t = __hip_atomic_fetch_add(ctl + CW_WQ + 64 * (l * 8 + bq), 1u, __ATOMIC_RELAXED, __HIP_MEMORY_SCOPE_AGENT) & 31u;
        unsigned* pd = ctl + CW_PDONE + 64 * (l * 64 + bq * 8 + 7 - (int)(t >> 2)); unsigned* ld = ctl + CW_LDONE + 64 * (l * 8 + bq); unsigned sp = 0;
        while (__hip_atomic_load(pd, __ATOMIC_RELAXED, __HIP_MEMORY_SCOPE_AGENT) < 8u || __hip_atomic_load(ld, __ATOMIC_RELAXED, __HIP_MEMORY_SCOPE_AGENT) < 16u) { __builtin_amdgcn_s_sleep(1); if (++sp > (1u << 22)) break; }
        group_acquire(group_mode(F.ws, (volatile LAS unsigned*)(F.lds + MISC_OFF + 232)));
        *slot = t; }
    __syncthreads();
    const int t = __builtin_amdgcn_readfirstlane((int)*slot);
    pg8::Gemm g{(const bf16_t*)(F.ws + WS_MIXED), (const bf16_t*)(wl + WO_WOUT), T, D, D}; OneUnit S{bq * 8 + 7 - (t >> 2), t & 3};
    EpiRes<true, l == 0> E{l == 0 ? (const void*)INP(F, IN_X) : (const void*)(F.ws + WS_XB), F.ws, l * NB * 6144 + 2048, (l * 2 + 1) * NB * D, 0};
    pg8::gemm_phase<EpiRes<true, l == 0>, OneUnit>(F.lds, F.lds + HALO_OFF, g, S, E, F.tid);
}
template <int l> __device__ __forceinline__ void ph_wout(const Frame& F) {
    unsigned char* wl = F.ws + WS_WTS + (size_t)l * WTS_LAYER;
    pg8::Gemm g{(const bf16_t*)(F.ws + WS_MIXED), (const bf16_t*)(wl + WO_WOUT), T, D, D}; pg8::StaticOrder S; S.init(T, D, F.G, F.bid);
    for (int rep_ = 0; rep_ < REPS(3); ++rep_) {
    EpiRes<true, l == 0> E{l == 0 ? (const void*)INP(F, IN_X) : (const void*)(F.ws + WS_XB), F.ws, l * NB * 6144 + 2048, (l * 2 + 1) * NB * D, rep_ ? 1 : 0};
    pg8::gemm_phase<EpiRes<true, l == 0>, pg8::StaticOrder>(F.lds, F.lds + HALO_OFF, g, S, E, F.tid); }
}
template <int l> __device__ __forceinline__ void ph_ffn1(const Frame& F) {
    unsigned char* wl = F.ws + WS_WTS + (size_t)l * WTS_LAYER;
    pg8::Gemm g{(const bf16_t*)(F.ws + WS_XG), (const bf16_t*)(wl + WO_WGU), T, NGU, D}; pg8::StaticOrder S; S.init(T, NGU, F.G, F.bid, 2);
    EpiGU E{F.ws, l};
    pg8::gemm_phase<EpiGU, pg8::StaticOrder>(F.lds, F.lds + HALO_OFF, g, S, E, F.tid);
}
template <int l> __device__ __forceinline__ void ph_ffn2(const Frame& F) {
    unsigned char* wl = F.ws + WS_WTS + (size_t)l * WTS_LAYER;
    pg8::Gemm g{(const bf16_t*)(F.ws + WS_ACT), (const bf16_t*)(wl + WO_WDN), T, D, FF}; pg8::StaticOrder S; S.init(T, D, F.G, F.bid);
    {   pg8::Unit u; for (int i = 0; S.next(i, u); ++i) fix_rows(F, l, u.pm);
        asm volatile("s_waitcnt vmcnt(0)" ::: "memory"); __syncthreads(); }
    if (l + 1 < NL) {
        for (int rep_ = REPS(5) - 1; rep_ >= 0; --rep_) {
        EpiRes<false, false> E{(const void*)(F.ws + WS_XB), F.ws, l * NB * 6144 + 5120, (l + 1) * 2 * NB * D, rep_ ? 2 : 0};
        pg8::gemm_phase<EpiRes<false, false>, pg8::StaticOrder>(F.lds, F.lds + HALO_OFF, g, S, E, F.tid); }
    } else {
        EpiFinal E{(const bf16_t*)(F.ws + WS_XB), F.out, F.ws, l * NB * 6144 + 5120, INP(F, IN_FING)};
        pg8::gemm_phase<EpiFinal, pg8::StaticOrder>(F.lds, F.lds + HALO_OFF, g, S, E, F.tid);
    }
}
#define LAYER(l) \
    PHASE_WIN(2 + 5 * (l) + 0, l) \
    PHASE_MIXW(2 + 5 * (l) + 1, l) \
    PHASE_G(2 + 5 * (l) + 3, for (int rep_ = 0; rep_ < REPS(4); ++rep_) { if (PHON(10)) ph_ffn1<l>(F); }) \
    PHASE_G(2 + 5 * (l) + 4, if (PHON(12)) ph_ffn2<l>(F);)

__global__ void __launch_bounds__(512, 2) fwd_kernel(Args args) {
    extern __shared__ __attribute__((aligned(16))) unsigned char lds_raw[];
    if (threadIdx.x == 0) { volatile LAS unsigned long long* inl = (volatile LAS unsigned long long*)((LAS unsigned char*)lds_raw + MISC_OFF);
#pragma unroll
        for (int i = 0; i < 29; ++i) inl[i] = (unsigned long long)args.in[i];
        inl[30] = 0ull;
        *(volatile LAS unsigned*)((LAS unsigned char*)lds_raw + MISC_OFF + 232) = 0u;
        *(volatile LAS unsigned*)((LAS unsigned char*)lds_raw + MISC_OFF + 236) = 0u;
#if MK_ONE_LAUNCH && !MK_CG_BARRIER
        (void)xb_add((unsigned*)(args.ws + WS_CTL) + 4096 + XB_XCNT(xb_xcc_id()), 1u);
        (void)__hip_atomic_fetch_or((unsigned*)(args.ws + WS_CTL) + CW_GROUPMASK + 64 * (blockIdx.x & 7), 1u << xb_xcc_id(), __ATOMIC_RELAXED, __HIP_MEMORY_SCOPE_AGENT);
#endif
    }
    __syncthreads();
#if MK_ONE_LAUNCH && MK_CG_BARRIER
    cg::grid_group grid = cg::this_grid();
#define GRID_BAR() grid.sync()
#define GROUP_BAR() grid.sync()
#define GST ((volatile LAS unsigned*)((LAS unsigned char*)lds_raw + MISC_OFF + 232))
    unsigned* xbar = (unsigned*)(args.ws + WS_CTL) + 4096; constexpr bool lru_early = false;
#elif MK_ONE_LAUNCH
    unsigned* xbar = (unsigned*)(args.ws + WS_CTL) + 4096;
    volatile LAS unsigned* xst = (volatile LAS unsigned*)((LAS unsigned char*)lds_raw + MISC_OFF + 240);
#define GRID_BAR() xcd_barrier(xbar, xst, wave0)
#define GST ((volatile LAS unsigned*)((LAS unsigned char*)lds_raw + MISC_OFF + 232))
    constexpr bool lru_early = true;
#define GROUP_BAR() do { if ((gridDim.x & 7u) == 0u) group_barrier(args.ws, xbar, (volatile LAS unsigned*)((LAS unsigned char*)lds_raw + MISC_OFF + 232), wave0); else xcd_barrier(xbar, xst, wave0); } while (0)
#else
#define GRID_BAR() do { } while (0)
#define GROUP_BAR() do { } while (0)
#define GST ((volatile LAS unsigned*)((LAS unsigned char*)lds_raw + MISC_OFF + 232))
    unsigned* xbar = (unsigned*)(args.ws + WS_CTL) + 4096; constexpr bool lru_early = false;
#endif
    const int wave0 = __builtin_amdgcn_readfirstlane(threadIdx.x >> 6);
    const int lo = args.ph_lo, hi = args.ph_hi;
    PHASE(0, for (int rep_ = 0; rep_ < REPS(100); ++rep_) { if (PHON(0)) { ph_mod(F); ph_convert(F); ph_posp(F); } })
    PHASE(1, for (int rep_ = 0; rep_ < REPS(101); ++rep_) { if (PHON(1)) ph_prep(F); })
    LAYER(0) LAYER(1) LAYER(2) LAYER(3)
}

extern "C" void kernel_launch(void* const* d_in, const int* in_sizes, int n_in, void* d_out, int out_size, void* d_ws, size_t ws_size, hipStream_t stream) {
    static int grid = 0;
    if (grid == 0) {
        if (n_in != 29 || out_size != T * D || ws_size < WS_END) { fprintf(stderr, "kernel_launch: unexpected problem (n_in %d out %d ws %zu)\n", n_in, out_size, ws_size); grid = -1; return; }
        int dev = 0, cus = 0, per_cu = 0;
        hipGetDevice(&dev); hipDeviceGetAttribute(&cus, hipDeviceAttributeMultiprocessorCount, dev);
        if (hipFuncSetAttribute((const void*)fwd_kernel, hipFuncAttributeMaxDynamicSharedMemorySize, LDS_BYTES) != hipSuccess) { fprintf(stderr, "kernel_launch: hipFuncSetAttribute failed\n"); grid = -1; return; }
        hipOccupancyMaxActiveBlocksPerMultiprocessor(&per_cu, (const void*)fwd_kernel, 512, LDS_BYTES);
        (void)hipGetLastError();
        if (per_cu < 1) fprintf(stderr, "kernel_launch: occupancy query says %d\n", per_cu);
        grid = cus;
        if (MK_ONE_LAUNCH && !MK_CG_BARRIER && cus != 256) { fprintf(stderr, "kernel_launch: this build's phase program assumes 256 CUs (got %d)\n", cus); grid = -1; return; }
    }
    if (grid < 0) return;
    Args a{};
    for (int i = 0; i < 29; ++i) a.in[i] = (const float*)d_in[i];
    a.out = (float*)d_out; a.ws = (unsigned char*)d_ws;
#if MK_ONE_LAUNCH
    a.ph_lo = 0; a.ph_hi = N_PHASES;
#if MK_CG_BARRIER
    void* kargs[] = {&a};
    hipError_t e = hipLaunchCooperativeKernel((const void*)fwd_kernel, dim3(grid), dim3(512), kargs, LDS_BYTES, stream);
    if (e != hipSuccess) fprintf(stderr, "cooperative launch failed: %s\n", hipGetErrorString(e));
#else
    if (hipMemsetAsync((char*)d_ws + WS_CTL, 0, CTL_ZERO_BYTES, stream) != hipSuccess) { fprintf(stderr, "kernel_launch: memset failed\n"); return; }
    hipLaunchKernelGGL(fwd_kernel, dim3(grid), dim3(512), LDS_BYTES, stream, a);
#endif
#else
    for (int ph = 0; ph < N_PHASES; ++ph) { a.ph_lo = ph; a.ph_hi = ph + 1; hipLaunchKernelGGL(fwd_kernel, dim3(grid), dim3(512), LDS_BYTES, stream, a); }
#endif
}
```
